# Optimizing an MI355X kernel written in HIP

```python
import math
import jax, jax.numpy as jnp
from jax import lax
import numpy as np

D_MODEL = 1024
BATCH = 2
SEQ = 16384
DEPTH = 4

N_EVEN = (DEPTH + 1) // 2
N_ODD = DEPTH // 2
EPS = 1e-6
ROPE_THETA = 10000.0
BLOCK = 128

A_HEADS = 8
A_KV_HEADS = 2
A_GROUP = A_HEADS // A_KV_HEADS
A_HEAD_DIM = D_MODEL // 16
A_WINDOW = 128
A_WIDTH = A_HEADS * A_HEAD_DIM
A_KV_WIDTH = A_KV_HEADS * A_HEAD_DIM
B_WIDTH = D_MODEL // 2
POOL_WINDOWS = (2, 4, 8, 16)
B_GROUPS = len(POOL_WINDOWS)
B_GROUP_DIM = B_WIDTH // B_GROUPS
EVEN_IN = A_WIDTH + 2 * A_KV_WIDTH + B_WIDTH
C_HEADS = 8
C_NOPE = 64
C_ROPE = 32
C_VDIM = 64
C_Q_RANK = D_MODEL // 4
C_KV_RANK = D_MODEL // 8
C_WIDTH = C_HEADS * C_VDIM
D_WIDTH = D_MODEL // 2
D_BLOCKS = 8
D_BLOCK_DIM = D_WIDTH // D_BLOCKS
CONV_WIDTH = 4
LRU_C = 8.0
ODD_IN = C_Q_RANK + C_KV_RANK + C_ROPE + 2 * D_WIDTH
D_FF = 4 * D_MODEL

kernel_name = "hybrid_bidir_swa_pool_mla_rglru"

F32 = jnp.float32


def rmsnorm(x, g):
    xf = x.astype(F32)
    y = xf * lax.rsqrt(jnp.mean(xf * xf, axis=-1, keepdims=True) + EPS)
    return (y * g.astype(F32)).astype(x.dtype)


def rope(x):
    S, d = x.shape[1], x.shape[-1]
    half = d // 2
    inv = ROPE_THETA ** (-jnp.arange(half, dtype=F32) / half)
    ang = jnp.arange(S, dtype=F32)[:, None] * inv[None, :]
    shape = (1, S) + (1,) * (x.ndim - 3) + (half,)
    cos = jnp.cos(ang).reshape(shape)
    sin = jnp.sin(ang).reshape(shape)
    xf = x.astype(F32)
    x1, x2 = xf[..., :half], xf[..., half:]
    return jnp.concatenate([x1 * cos - x2 * sin, x2 * cos + x1 * sin], axis=-1).astype(x.dtype)


def windowed_gqa(q, k, v, sink):
    Bsz, S = q.shape[0], q.shape[1]
    nb = S // BLOCK
    qb = q.reshape(Bsz, nb, BLOCK, A_KV_HEADS, A_GROUP, A_HEAD_DIM)

    def band(t):
        tp = jnp.pad(t, ((0, 0), (BLOCK, BLOCK), (0, 0), (0, 0)))
        tp = tp.reshape(Bsz, nb + 2, BLOCK, A_KV_HEADS, A_HEAD_DIM)
        return jnp.concatenate([tp[:, :-2], tp[:, 1:-1], tp[:, 2:]], axis=2)

    kb, vb = band(k), band(v)
    s = jnp.einsum('bnqhgd,bnjhd->bnhgqj', qb, kb).astype(F32) * (A_HEAD_DIM ** -0.5)
    blk = jnp.arange(nb)[:, None, None]
    qpos = blk * BLOCK + jnp.arange(BLOCK)[None, :, None]
    kpos = (blk - 1) * BLOCK + jnp.arange(3 * BLOCK)[None, None, :]
    valid = (jnp.abs(kpos - qpos) <= A_WINDOW) & (kpos >= 0) & (kpos < S)
    s = jnp.where(valid[None, :, None, None], s, -jnp.inf)
    sk = sink.astype(F32).reshape(1, 1, A_KV_HEADS, A_GROUP, 1, 1)
    m = jnp.maximum(jnp.max(s, axis=-1, keepdims=True), sk)
    p = jnp.exp(s - m)
    p = p / (jnp.sum(p, axis=-1, keepdims=True) + jnp.exp(sk - m))
    out = jnp.einsum('bnhgqj,bnjhd->bnqhgd', p.astype(v.dtype), vb)
    return out.reshape(Bsz, S, A_WIDTH)


def multiscale_pool(u, w_pool, pool_scale):
    Bsz, S = u.shape[0], u.shape[1]
    uf = u.astype(F32).reshape(Bsz, S, B_GROUPS, B_GROUP_DIM)
    cs = jnp.pad(jnp.cumsum(uf, axis=1), ((0, 0), (1, 0), (0, 0), (0, 0)))
    t = jnp.arange(S)
    outs = []
    for g, w in enumerate(POOL_WINDOWS):
        half = w // 2
        lo = jnp.clip(t - half, 0, S)
        hi = jnp.clip(t + half, 0, S)
        win_sum = cs[:, hi, g] - cs[:, lo, g]
        cnt = (hi - lo).astype(F32)[None, :, None]
        outs.append(win_sum / cnt - uf[:, :, g])
    d = jnp.stack(outs, axis=2)
    y = jnp.einsum('bsgi,gij->bsgj', d, w_pool.astype(F32)).reshape(Bsz, S, B_WIDTH)
    return (y * pool_scale.astype(F32)).astype(u.dtype)


def dense_mla(qn, qr, kn, kr, v):
    Bsz, S = qn.shape[0], qn.shape[1]
    nb = S // BLOCK
    scale = (C_NOPE + C_ROPE) ** -0.5

    def blocks(t):
        return jnp.moveaxis(t.reshape((Bsz, nb, BLOCK) + t.shape[2:]), 1, 0)

    def one(args):
        qn_b, qr_b = args
        s = (jnp.einsum('bqhd,bkhd->bhqk', qn_b, kn) + jnp.einsum('bqhr,bkr->bhqk', qr_b, kr)).astype(F32) * scale
        p = jax.nn.softmax(s, axis=-1).astype(v.dtype)
        return jnp.einsum('bhqk,bkhd->bqhd', p, v)

    out = lax.map(one, (blocks(qn), blocks(qr)))
    return jnp.moveaxis(out, 0, 1).reshape(Bsz, S, C_WIDTH)


def _lin_combine(left, right):
    a1, b1 = left
    a2, b2 = right
    return a1 * a2, a2 * b1 + b2


def rglru_block(xr, xg, conv_w, conv_b, wa, ba, wx, bx, lam):
    Bsz, S = xr.shape[0], xr.shape[1]
    left = CONV_WIDTH // 2
    xp = jnp.pad(xr, ((0, 0), (left, CONV_WIDTH - 1 - left), (0, 0)))
    xc = conv_b + conv_w[0] * xp[:, 0:S]
    for j in range(1, CONV_WIDTH):
        xc = xc + conv_w[j] * xp[:, j:j + S]
    xcf = xc.astype(F32)
    xblk = xcf.reshape(Bsz, S, D_BLOCKS, D_BLOCK_DIM)
    hs = []
    for dirn in range(2):
        r = jax.nn.sigmoid(jnp.einsum('bsni,nij->bsnj', xblk, wa[dirn].astype(F32)).reshape(Bsz, S, D_WIDTH) + ba[dirn].astype(F32))
        i = jax.nn.sigmoid(jnp.einsum('bsni,nij->bsnj', xblk, wx[dirn].astype(F32)).reshape(Bsz, S, D_WIDTH) + bx[dirn].astype(F32))
        log_a = -LRU_C * r * jax.nn.softplus(-lam[dirn].astype(F32))
        a = jnp.exp(log_a)
        b = jnp.sqrt(-jnp.expm1(2.0 * log_a)) * (i * xcf)
        _, h = lax.associative_scan(_lin_combine, (a, b), axis=1, reverse=(dirn == 1))
        hs.append(h)
    y = (hs[0] + hs[1]) * jax.nn.gelu(xg.astype(F32))
    return y.astype(xr.dtype)


def even_mixer(h, w_in, sink, w_pool, pool_scale, w_out):
    Bsz, S = h.shape[0], h.shape[1]
    z = h @ w_in
    q, k, v, u = jnp.split(z, [A_WIDTH, A_WIDTH + A_KV_WIDTH, A_WIDTH + 2 * A_KV_WIDTH], axis=-1)
    q = rope(q.reshape(Bsz, S, A_HEADS, A_HEAD_DIM))
    k = rope(k.reshape(Bsz, S, A_KV_HEADS, A_HEAD_DIM))
    v = v.reshape(Bsz, S, A_KV_HEADS, A_HEAD_DIM)
    ya = windowed_gqa(q, k, v, sink)
    yb = multiscale_pool(u, w_pool, pool_scale)
    return jnp.concatenate([ya, yb], axis=-1) @ w_out


def odd_mixer(h, w_in, g_cq, w_uq, g_ckv, w_ukv, conv_w, conv_b, wa, ba, wx, bx, lam, w_out):
    Bsz, S = h.shape[0], h.shape[1]
    z = h @ w_in
    i1 = C_Q_RANK
    i2 = i1 + C_KV_RANK
    i3 = i2 + C_ROPE
    i4 = i3 + D_WIDTH
    cq, ckv, kr, xr, xg = jnp.split(z, [i1, i2, i3, i4], axis=-1)
    q = (rmsnorm(cq, g_cq) @ w_uq).reshape(Bsz, S, C_HEADS, C_NOPE + C_ROPE)
    qn, qr = q[..., :C_NOPE], rope(q[..., C_NOPE:])
    kv = (rmsnorm(ckv, g_ckv) @ w_ukv).reshape(Bsz, S, C_HEADS, C_NOPE + C_VDIM)
    kn, v = kv[..., :C_NOPE], kv[..., C_NOPE:]
    yc = dense_mla(qn, qr, kn, rope(kr), v)
    yd = rglru_block(xr, xg, conv_w, conv_b, wa, ba, wx, bx, lam)
    return jnp.concatenate([yc, yd], axis=-1) @ w_out


def sq_relu_mlp(h, w1, w2):
    u = jax.nn.relu(h @ w1)
    return (u * u) @ w2


def setup_inputs(seed: int = 0) -> dict:
    key = jax.random.key(seed)
    ks = iter(jax.random.split(key, 40))

    def nrm(shape, fan_in):
        return jax.random.normal(next(ks), shape, F32) * (fan_in ** -0.5)

    def gain(shape):
        return 1.0 + 0.02 * jax.random.normal(next(ks), shape, F32)

    def bias(shape):
        return 0.01 * jax.random.normal(next(ks), shape, F32)

    x = jax.random.normal(next(ks), (BATCH, SEQ, D_MODEL), F32)
    u = jax.random.uniform(next(ks), (N_ODD, 2, D_WIDTH), F32, 0.9, 0.999)
    a0 = u ** (1.0 / LRU_C)
    lam = jnp.log(a0) - jnp.log1p(-a0)
    return {
        "x": x,
        "e_norm_mix": gain((N_EVEN, D_MODEL)),
        "e_w_in": nrm((N_EVEN, D_MODEL, EVEN_IN), D_MODEL),
        "e_sink": 0.5 * jax.random.normal(next(ks), (N_EVEN, A_HEADS), F32),
        "e_w_pool": nrm((N_EVEN, B_GROUPS, B_GROUP_DIM, B_GROUP_DIM), B_GROUP_DIM),
        "e_pool_scale": gain((N_EVEN, B_WIDTH)),
        "e_w_out": nrm((N_EVEN, D_MODEL, D_MODEL), D_MODEL),
        "o_norm_mix": gain((N_ODD, D_MODEL)),
        "o_w_in": nrm((N_ODD, D_MODEL, ODD_IN), D_MODEL),
        "o_g_cq": gain((N_ODD, C_Q_RANK)),
        "o_w_uq": nrm((N_ODD, C_Q_RANK, C_HEADS * (C_NOPE + C_ROPE)), C_Q_RANK),
        "o_g_ckv": gain((N_ODD, C_KV_RANK)),
        "o_w_ukv": nrm((N_ODD, C_KV_RANK, C_HEADS * (C_NOPE + C_VDIM)), C_KV_RANK),
        "o_conv_w": nrm((N_ODD, CONV_WIDTH, D_WIDTH), CONV_WIDTH),
        "o_conv_b": bias((N_ODD, D_WIDTH)),
        "o_lru_wa": nrm((N_ODD, 2, D_BLOCKS, D_BLOCK_DIM, D_BLOCK_DIM), D_BLOCK_DIM),
        "o_lru_ba": bias((N_ODD, 2, D_WIDTH)),
        "o_lru_wx": nrm((N_ODD, 2, D_BLOCKS, D_BLOCK_DIM, D_BLOCK_DIM), D_BLOCK_DIM),
        "o_lru_bx": bias((N_ODD, 2, D_WIDTH)),
        "o_lru_lambda": lam,
        "o_w_out": nrm((N_ODD, D_MODEL, D_MODEL), D_MODEL),
        "norm_mlp": gain((DEPTH, D_MODEL)),
        "w_mlp1": nrm((DEPTH, D_MODEL, D_FF), D_MODEL),
        "w_mlp2": nrm((DEPTH, D_FF, D_MODEL), D_FF),
        "final_norm": gain((D_MODEL,)),
    }


def reference(x, e_norm_mix, e_w_in, e_sink, e_w_pool, e_pool_scale, e_w_out,
              o_norm_mix, o_w_in, o_g_cq, o_w_uq, o_g_ckv, o_w_ukv, o_conv_w, o_conv_b,
              o_lru_wa, o_lru_ba, o_lru_wx, o_lru_bx, o_lru_lambda, o_w_out,
              norm_mlp, w_mlp1, w_mlp2, final_norm):
    for layer in range(DEPTH):
        if layer % 2 == 0:
            e = layer // 2
            h = rmsnorm(x, e_norm_mix[e])
            x = x + even_mixer(h, e_w_in[e], e_sink[e], e_w_pool[e], e_pool_scale[e], e_w_out[e])
        else:
            o = layer // 2
            h = rmsnorm(x, o_norm_mix[o])
            x = x + odd_mixer(h, o_w_in[o], o_g_cq[o], o_w_uq[o], o_g_ckv[o], o_w_ukv[o],
                              o_conv_w[o], o_conv_b[o], o_lru_wa[o], o_lru_ba[o], o_lru_wx[o],
                              o_lru_bx[o], o_lru_lambda[o], o_w_out[o])
        x = x + sq_relu_mlp(rmsnorm(x, norm_mlp[layer]), w_mlp1[layer], w_mlp2[layer])
    return rmsnorm(x, final_norm)
```

```cpp
#include <hip/hip_runtime.h>
#include <hip/hip_cooperative_groups.h>
#include <cstdio>
#include <cstdint>
#include <cmath>
namespace cg = cooperative_groups;
namespace pg8 {
#define PG8_LAS __attribute__((address_space(3)))
typedef unsigned short bf16_t;
typedef short bf16x8 __attribute__((ext_vector_type(8)));
typedef float f32x4 __attribute__((ext_vector_type(4)));
typedef unsigned u32x4 __attribute__((ext_vector_type(4)));
constexpr int BM = 256, BK = 64, HALF = 128, HTB = HALF * BK * 2  , STAGE_BYTES = 8 * HTB, NXCD = 8, WGM = 8;

__host__ __device__ __forceinline__ int lds_byte(int r, int c) { const int st = (r >> 4) * 2 + (c >> 5), rr = r & 15, cc = c & 31, ob = rr * 64 + cc * 2; return st * 1024 + (ob ^ (((ob >> 9) & 1) << 5)); }
__host__ __device__ __forceinline__ void stage_rc(int b, int& R, int& C) { const int st = b / 1024, sb = b % 1024, swz = sb ^ (((sb >> 9) & 1) << 5); R = (st >> 1) * 16 + swz / 64; C = (st & 1) * 32 + (swz % 64) / 2; }
__host__ __device__ __forceinline__ int perm32(int rho) { const int n = rho >> 4, i = rho & 15; return 8 * (i >> 2) + 4 * n + (i & 3); }

struct Unit { int pm, pn; };
struct Gemm { const bf16_t* A; const bf16_t* Bt; int M, N, K; int wv; };

struct StaticOrder {
    int nM, nN, nwg, G, c;
    __host__ __device__ void init(int M, int N, int G_, int c_) { nM = M / BM; nN = N / BM; nwg = nM * nN; G = G_; c = c_; }
    __host__ __device__ bool next(int i, Unit& u) const {
        const long L = (long)i * G + c; if (L >= nwg) return false;
        int wgid = (int)L; { const int q = nwg / NXCD, r = nwg % NXCD, xcd = wgid % NXCD, off = wgid / NXCD; wgid = (xcd < r ? xcd * (q + 1) : r * (q + 1) + (xcd - r) * q) + off; }
        const int nig = WGM * nN, gid = wgid / nig, fm = gid * WGM, gsz = (nM - fm) < WGM ? (nM - fm) : WGM;
        u.pm = fm + ((wgid % nig) % gsz); u.pn = (wgid % nig) / gsz; return true;
    }
    __device__ __forceinline__ void a_ready(const Unit&) const {}
    __device__ __forceinline__ void done(const Unit&) const {}
};

__device__ __forceinline__ unsigned cvt_pk_bf16(float lo, float hi) { unsigned r; asm volatile("v_cvt_pk_bf16_f32 %0, %1, %2" : "=v"(r) : "v"(lo), "v"(hi)); return r; }
typedef float f32x2 __attribute__((ext_vector_type(2)));
template <class Epi, class Sched, bool ALIGN_EPI = false, bool SP2 = false>
__device__ __forceinline__ void gemm_phase(PG8_LAS unsigned char* lds, const Gemm g, const Sched& S, const Epi& E) {
    int lid_; asm volatile("v_mbcnt_lo_u32_b32 %0, -1, 0\n\tv_mbcnt_hi_u32_b32 %0, -1, %0" : "=v"(lid_)); int tid_ = g.wv * 64 + lid_;
    const int tid = tid_, wid = __builtin_amdgcn_readfirstlane(tid >> 6), lane = tid & 63, wr = wid >> 2, wc = wid & 3, fr = lane & 15, fq = lane >> 4;
    int K_ = g.K; asm volatile("" : "+s"(K_)); const int K = K_, nt = K / BK;
    unsigned voffA[2], voffB[2];
#pragma unroll
    for (int i = 0; i < 2; ++i) { int R, C; stage_rc(tid * 16 + i * 8192, R, C); const int Rb = Epi::PERM ? ((R & ~31) + perm32(R & 31)) : R;
        voffA[i] = (unsigned)(R * K + C) * 2u; voffB[i] = (unsigned)(Rb * K + C) * 2u; }
    const size_t kstep = (size_t)(BK * 2);
    const size_t hstep = (size_t)HALF * K * 2;
    const size_t tstep = 2 * hstep;
    const unsigned ldsw = (unsigned)wid * 1024u;
    const int aoff = lds_byte(wr * 64 + fr, fq * 8), boff = lds_byte(wc * 32 + fr, fq * 8);
#define PG8_SA(b, h) (((b) * 2 + (h)) * HTB)
#define PG8_SB(b, h) ((4 + (b) * 2 + (h)) * HTB)
#define PG8_STAGE(bufoff, gbase, voff) do { _Pragma("unroll") for (int _i = 0; _i < 2; ++_i) \
        __builtin_amdgcn_global_load_lds((const unsigned*)((const char*)(gbase) + (voff)[_i]), (PG8_LAS unsigned*)(lds + (bufoff) + ldsw + _i * 8192), 16, 0, 0); } while (0)
#define PG8_LDA(dst, b, h) do { _Pragma("unroll") for (int m = 0; m < 4; ++m) _Pragma("unroll") for (int k = 0; k < 2; ++k) dst[m][k] = *(const PG8_LAS bf16x8*)(lds + PG8_SA(b, h) + aoff + m * 2048 + k * 1024); } while (0)
#define PG8_LDB(dst, b, h) do { _Pragma("unroll") for (int n = 0; n < 2; ++n) _Pragma("unroll") for (int k = 0; k < 2; ++k) dst[n][k] = *(const PG8_LAS bf16x8*)(lds + PG8_SB(b, h) + boff + n * 2048 + k * 1024); } while (0)
#define PG8_MMA(ai, bj, At, Bt) do { __builtin_amdgcn_s_setprio(1); _Pragma("unroll") for (int m = 0; m < 4; ++m) _Pragma("unroll") for (int n = 0; n < 2; ++n) _Pragma("unroll") for (int k = 0; k < 2; ++k) \
        acc[ai][bj][m][n] = __builtin_amdgcn_mfma_f32_16x16x32_bf16(Bt[n][k], At[m][k], acc[ai][bj][m][n], 0, 0, 0); __builtin_amdgcn_s_setprio(0); } while (0)
#define PG8_WAIT_V(n) asm volatile("s_waitcnt vmcnt(" #n ")" ::: "memory")
#define PG8_WAIT_L(n) asm volatile("s_waitcnt lgkmcnt(" #n ")" ::: "memory")
#define PG8_BAR __builtin_amdgcn_s_barrier()
#define PG8_SCHED __builtin_amdgcn_sched_barrier(0)
    Unit cur, nxt; int ui = 0;
    if (!S.next(0, cur)) return;
    f32x4 acc[2][2][4][2];
#pragma unroll
    for (int a = 0; a < 2; ++a)
#pragma unroll
        for (int b = 0; b < 2; ++b)
#pragma unroll
            for (int m = 0; m < 4; ++m)
#pragma unroll
                for (int n = 0; n < 2; ++n) acc[a][b][m][n] = (f32x4){0.f, 0.f, 0.f, 0.f};
    bf16x8 At[4][2], B0[2][2], B1[2][2];
    const char* cA = (const char*)g.A + (size_t)cur.pm * tstep; const char* cB = (const char*)g.Bt + (size_t)cur.pn * tstep;
    S.a_ready(cur);
    if constexpr (SP2) {
        PG8_STAGE(PG8_SB(0, 0), cB, voffB); PG8_STAGE(PG8_SB(0, 1), cB + hstep, voffB); PG8_STAGE(PG8_SA(0, 0), cA, voffA); PG8_STAGE(PG8_SA(0, 1), cA + hstep, voffA);
        if (wr == 1) PG8_BAR;
        PG8_WAIT_V(2); PG8_BAR;
        PG8_STAGE(PG8_SB(1, 0), cB + kstep, voffB); PG8_STAGE(PG8_SA(1, 0), cA + kstep, voffA); PG8_STAGE(PG8_SB(1, 1), cB + hstep + kstep, voffB);
        PG8_WAIT_V(6); PG8_BAR;
    } else {
        PG8_STAGE(PG8_SB(0, 0), cB, voffB); PG8_STAGE(PG8_SA(0, 0), cA, voffA); PG8_STAGE(PG8_SB(0, 1), cB + hstep, voffB); PG8_STAGE(PG8_SA(0, 1), cA + hstep, voffA);
        if (wr == 1) PG8_BAR;
        PG8_WAIT_V(4); PG8_BAR;
        PG8_STAGE(PG8_SB(1, 0), cB + kstep, voffB); PG8_STAGE(PG8_SA(1, 0), cA + kstep, voffA); PG8_STAGE(PG8_SB(1, 1), cB + hstep + kstep, voffB);
        PG8_WAIT_V(6); PG8_BAR;
    }
    for (;;) {
        const bool has_next = S.next(ui + 1, nxt);
        const char* nA = has_next ? (const char*)g.A + (size_t)nxt.pm * tstep : cA; const char* nB = has_next ? (const char*)g.Bt + (size_t)nxt.pn * tstep : cB;
        asm volatile(".p2align 6" ::: "memory");
        for (int t = 0; t < nt; t += 2) {
            const bool last = (t == nt - 2);
            const char* a1 = cA + (size_t)(t + 1) * kstep;
            const char* a2 = last ? nA : cA + (size_t)(t + 2) * kstep; const char* b2 = last ? nB : cB + (size_t)(t + 2) * kstep;
            const char* a3 = a2 + kstep; const char* b3 = b2 + kstep;
            if (last && has_next) S.a_ready(nxt);
            if constexpr (SP2) {
            PG8_LDB(B0, 0, 0); PG8_LDB(B1, 0, 1); PG8_SCHED; PG8_LDA(At, 0, 0); PG8_STAGE(PG8_SA(1, 1), a1 + hstep, voffA);
            PG8_WAIT_V(8); PG8_WAIT_L(0); PG8_BAR; PG8_MMA(0, 0, At, B0); PG8_MMA(0, 1, At, B1); PG8_BAR; PG8_SCHED;
            PG8_LDA(At, 0, 1); PG8_STAGE(PG8_SB(0, 0), b2, voffB); PG8_STAGE(PG8_SB(0, 1), b2 + hstep, voffB); PG8_STAGE(PG8_SA(0, 0), a2, voffA);
            PG8_WAIT_V(8); PG8_WAIT_L(0); PG8_BAR; PG8_MMA(1, 0, At, B0); PG8_MMA(1, 1, At, B1); PG8_BAR; PG8_SCHED;
            PG8_LDB(B0, 1, 0); PG8_LDB(B1, 1, 1); PG8_SCHED; PG8_LDA(At, 1, 0); PG8_STAGE(PG8_SA(0, 1), a2 + hstep, voffA);
            PG8_WAIT_V(8); PG8_WAIT_L(0); PG8_BAR; PG8_MMA(0, 0, At, B0); PG8_MMA(0, 1, At, B1); PG8_BAR; PG8_SCHED;
            PG8_LDA(At, 1, 1); PG8_STAGE(PG8_SB(1, 0), b3, voffB); PG8_STAGE(PG8_SB(1, 1), b3 + hstep, voffB); PG8_STAGE(PG8_SA(1, 0), a3, voffA);
            PG8_WAIT_V(8); PG8_WAIT_L(0); PG8_BAR; PG8_MMA(1, 0, At, B0); PG8_MMA(1, 1, At, B1); PG8_BAR; PG8_SCHED;
            } else {
            PG8_LDB(B0, 0, 0); PG8_SCHED; PG8_LDA(At, 0, 0); PG8_STAGE(PG8_SA(1, 1), a1 + hstep, voffA);
            PG8_WAIT_L(8); PG8_BAR; PG8_WAIT_L(0); PG8_MMA(0, 0, At, B0); PG8_BAR; PG8_SCHED;
            PG8_LDB(B1, 0, 1); PG8_STAGE(PG8_SB(0, 0), b2, voffB);
            PG8_BAR; PG8_WAIT_L(0); PG8_MMA(0, 1, At, B1); PG8_BAR;
            PG8_LDA(At, 0, 1); PG8_STAGE(PG8_SA(0, 0), a2, voffA);
            PG8_BAR; PG8_WAIT_L(0); PG8_MMA(1, 0, At, B0); PG8_BAR; PG8_SCHED;
            PG8_STAGE(PG8_SB(0, 1), b2 + hstep, voffB);
            PG8_WAIT_V(6); PG8_BAR; PG8_MMA(1, 1, At, B1); PG8_BAR;
            PG8_LDB(B0, 1, 0); PG8_SCHED; PG8_LDA(At, 1, 0); PG8_STAGE(PG8_SA(0, 1), a2 + hstep, voffA);
            PG8_WAIT_L(8); PG8_BAR; PG8_WAIT_L(0); PG8_MMA(0, 0, At, B0); PG8_BAR; PG8_SCHED;
            PG8_LDB(B1, 1, 1); PG8_STAGE(PG8_SB(1, 0), b3, voffB);
            PG8_BAR; PG8_WAIT_L(0); PG8_MMA(0, 1, At, B1); PG8_BAR;
            PG8_LDA(At, 1, 1); PG8_STAGE(PG8_SA(1, 0), a3, voffA);
            PG8_BAR; PG8_WAIT_L(0); PG8_MMA(1, 0, At, B0); PG8_BAR; PG8_SCHED;
            PG8_STAGE(PG8_SB(1, 1), b3 + hstep, voffB);
            PG8_WAIT_V(6); PG8_BAR; PG8_MMA(1, 1, At, B1); PG8_BAR;
            }
        }
        if constexpr (ALIGN_EPI) { if (wr == 0) PG8_BAR; }
        if constexpr (!Epi::AFTER_DRAIN) { E(acc, cur, wr, wc, fr, fq); S.done(cur); }
        if (!has_next) break;
#pragma unroll
        for (int a = 0; a < 2; ++a)
#pragma unroll
            for (int b = 0; b < 2; ++b)
#pragma unroll
                for (int m = 0; m < 4; ++m)
#pragma unroll
                    for (int n = 0; n < 2; ++n) acc[a][b][m][n] = (f32x4){0.f, 0.f, 0.f, 0.f};
        cur = nxt; cA = nA; cB = nB; ++ui;
        if constexpr (ALIGN_EPI) { if (wr == 1) PG8_BAR; }
    }
    PG8_WAIT_V(0);
    if constexpr (!ALIGN_EPI) { if (wr == 0) PG8_BAR; }
    PG8_BAR;
    if constexpr (Epi::AFTER_DRAIN) { E.fused(acc, cur, wr, wc, fr, fq, lds, wid, lane); S.done(cur); }
#undef PG8_SA
#undef PG8_SB
#undef PG8_STAGE
#undef PG8_LDA
#undef PG8_LDB
#undef PG8_MMA
#undef PG8_WAIT_V
#undef PG8_WAIT_L
#undef PG8_BAR
#undef PG8_SCHED
}
}
#ifndef MLA_REP
#define MLA_REP 1
#endif
#ifndef PRO_REP
#define PRO_REP 1
#endif
#ifndef WIN_REP
#define WIN_REP 1
#endif
#ifndef LRU_REP
#define LRU_REP 1
#endif
#ifndef M1_REP
#define M1_REP 1
#endif
#ifndef E1_REP
#define E1_REP 1
#endif
#ifndef O1_REP
#define O1_REP 1
#endif
#ifndef O2_REP
#define O2_REP 1
#endif
#ifndef SYNC_EXTRA
#define SYNC_EXTRA 0
#endif
#ifndef MLA_SGB
#define MLA_SGB 1
#endif
#ifndef PH
#define PH 0xFFFF
#endif

constexpr int BATCH = 2, SEQ = 16384, DM = 1024, MTOK = BATCH * SEQ, DFF = 4096, DEPTH = 4;
constexpr float EPS = 1e-6f, LOG2E = 1.4426950408889634f;
constexpr float QSCALE_A = 0.125f * LOG2E;
constexpr float QSCALE_C = 0.10206207261596577f * LOG2E;

#define LAS __attribute__((address_space(3)))
#define DI __device__ __forceinline__
typedef unsigned short bf16;
typedef short bf16x8 __attribute__((ext_vector_type(8)));
typedef short s16x4 __attribute__((ext_vector_type(4)));
typedef float f32x4 __attribute__((ext_vector_type(4)));
typedef float f32x2 __attribute__((ext_vector_type(2)));
typedef float f32x16 __attribute__((ext_vector_type(16)));
typedef unsigned u32x4 __attribute__((ext_vector_type(4)));
typedef unsigned u32x2 __attribute__((ext_vector_type(2)));
#define MFMA32(a, b, c) __builtin_amdgcn_mfma_f32_32x32x16_bf16((a), (b), (c), 0, 0, 0)

constexpr size_t MiB = (size_t)1 << 20;
constexpr size_t WS_CTL = 0, CTL_ZERO_BYTES = 16384, WS_SP = 65536;
constexpr size_t WS_EIN = 1 * MiB, WS_EOUT = 6 * MiB, WS_OIN = 10 * MiB, WS_UQ = 16 * MiB, WS_UKV = 17 * MiB, WS_OOUT = 18 * MiB;
constexpr size_t WS_M1 = 22 * MiB, WS_M2 = 54 * MiB, WS_WG = 86 * MiB, WS_ROPA = 87 * MiB, WS_ROPC = 91 * MiB;
constexpr size_t WS_SSP = 93 * MiB, WS_SSQ = 95 * MiB, WS_SSKV = 96 * MiB, WS_SUM = 97 * MiB, WS_CSUM = 105 * MiB;
constexpr size_t WS_XB = 112 * MiB, WS_Y = 176 * MiB, WS_H = 240 * MiB;
constexpr size_t WS_Q = 240 * MiB, WS_K = 272 * MiB, WS_V = 280 * MiB, WS_U = 288 * MiB;
constexpr size_t WS_CQ = 240 * MiB, WS_CKV = 256 * MiB, WS_KR = 264 * MiB, WS_XR = 272 * MiB, WS_GXG = 304 * MiB;
constexpr size_t WS_QM = 336 * MiB, WS_KN = 384 * MiB, WS_VM = 420 * MiB;
constexpr int KROW = 544;
constexpr size_t WS_END = 496 * MiB;
constexpr int LDS_BYTES = 147456;

struct Params { const float* in[25]; float* out; unsigned char* ws; };

DI unsigned cvtpk(float lo, float hi) { typedef __bf16 b2 __attribute__((ext_vector_type(2))); f32x2 v = {lo, hi}; b2 b = __builtin_convertvector(v, b2); return __builtin_bit_cast(unsigned, b); }
DI float bflo(unsigned w) { return __uint_as_float(w << 16); }
DI float bfhi(unsigned w) { return __uint_as_float(w & 0xffff0000u); }
DI u32x4 pack8(const float (&v)[8]) { u32x4 o; o.x = cvtpk(v[0], v[1]); o.y = cvtpk(v[2], v[3]); o.z = cvtpk(v[4], v[5]); o.w = cvtpk(v[6], v[7]); return o; }
DI void unpack8(const u32x4 w, float (&v)[8]) { v[0] = bflo(w.x); v[1] = bfhi(w.x); v[2] = bflo(w.y); v[3] = bfhi(w.y); v[4] = bflo(w.z); v[5] = bfhi(w.z); v[6] = bflo(w.w); v[7] = bfhi(w.w); }
DI float sigm(float x) { return 1.f / (1.f + __expf(-x)); }
DI float gelu_tanh(float x) { const float u = 0.7978845608028654f * (x + 0.044715f * x * x * x); const float e = __expf(2.f * u); const float t = 1.f - 2.f / (e + 1.f); return 0.5f * x * (1.f + t); }
DI int lane_id() { int l; asm volatile("v_mbcnt_lo_u32_b32 %0, -1, 0\n\tv_mbcnt_hi_u32_b32 %0, -1, %0" : "=v"(l)); return l; }
DI int crow(int i, int h) { return (i & 3) + 8 * (i >> 2) + 4 * h; }
DI float swap_max(float v) { auto rr = __builtin_amdgcn_permlane32_swap(__float_as_uint(v), __float_as_uint(v), false, false); return fmaxf(__uint_as_float(rr[0]), __uint_as_float(rr[1])); }
DI float swap_sum(float v) { auto rr = __builtin_amdgcn_permlane32_swap(__float_as_uint(v), __float_as_uint(v), false, false); return __uint_as_float(rr[0]) + __uint_as_float(rr[1]); }
DI s16x4 vtr(const LAS unsigned char* p) { typedef short v4i16_t __attribute__((ext_vector_type(4))); return __builtin_bit_cast(s16x4, __builtin_amdgcn_ds_read_tr16_b64_v4i16((LAS v4i16_t*)p)); }
DI void sincos_acc(float angf, float& s, float& c) {
    const double a = (double)angf;
    const double q = rint(a * 0.6366197723675814);
    double r = a - q * 1.5707963267948966; r = r - q * 6.123233995736766e-17;
    const double r2 = r * r;
    const double sp = r * (1.0 + r2 * (-1.0 / 6 + r2 * (1.0 / 120 + r2 * (-1.0 / 5040 + r2 * (1.0 / 362880 + r2 * (-1.0 / 39916800 + r2 * (1.0 / 6227020800.0 + r2 * (-1.0 / 1307674368000.0))))))));
    const double cp = 1.0 + r2 * (-0.5 + r2 * (1.0 / 24 + r2 * (-1.0 / 720 + r2 * (1.0 / 40320 + r2 * (-1.0 / 3628800 + r2 * (1.0 / 479001600.0 + r2 * (-1.0 / 87178291200.0 + r2 * (1.0 / 20922789888000.0))))))));
    const int qi = (int)((long long)q & 3);
    const double ss = (qi == 0) ? sp : (qi == 1) ? cp : (qi == 2) ? -sp : -cp;
    const double cc = (qi == 0) ? cp : (qi == 1) ? -sp : (qi == 2) ? -cp : sp;
    s = (float)ss; c = (float)cc;
}

template <class F>
DI void conv_wt(const float* __restrict__ W, int K, int Nsrc, bf16* __restrict__ Bt, int Ndst, int ldb, int kdst_off, const float* __restrict__ gain, F colmap, LAS float* scr, int lane, int gw, int ngw) {
    const int nkt = K / 64, nnt = Ndst / 64, items = nkt * nnt;
    for (int it = gw; it < items; it += ngw) {
        const int nb = it % nnt, kb = it / nnt, n0 = nb * 64, k0 = kb * 64;
        const int src = colmap(n0 + lane);
        const float* wp = W + (size_t)k0 * Nsrc + (src < 0 ? 0 : src);
        float wv[64];
#pragma unroll
        for (int kk = 0; kk < 64; ++kk) wv[kk] = wp[(size_t)kk * Nsrc];
#pragma unroll
        for (int kk = 0; kk < 64; ++kk) { float w = wv[kk]; if (gain) w *= gain[k0 + kk]; scr[kk * 65 + lane] = (src < 0) ? 0.f : w; }
        asm volatile("s_waitcnt lgkmcnt(0)" ::: "memory");
        const int c = lane & 7;
#pragma unroll
        for (int j = 0; j < 8; ++j) { const int n = (lane >> 3) + 8 * j; const LAS float* sp = scr + (8 * c) * 65 + n;
            float v[8];
#pragma unroll
            for (int q = 0; q < 8; ++q) v[q] = sp[q * 65];
            *(u32x4*)(Bt + (size_t)(n0 + n) * ldb + kdst_off + k0 + 8 * c) = pack8(v); }
        asm volatile("s_waitcnt lgkmcnt(0)" ::: "memory");
    }
}
struct MapId { DI int operator()(int n) const { return n; } };
struct MapEin { DI int operator()(int n) const { if (n >= 640) return n; const int base = n & ~63, i = n & 63; return base + (i >> 1) + 32 * (i & 1); } };
struct MapOin { DI int operator()(int n) const {
    if (n < 384) return n;
    if (n < 416) { const int i = n - 384; return 384 + (i >> 1) + 16 * (i & 1); }
    if (n < 512) return -1;
    if (n < 1024) return 416 + (n - 512);
    return 928 + (n - 1024); } };
struct MapUq { DI int operator()(int n) const { const int h = n / 96, w = n - 96 * h; if (w < 64) return n; const int i = w - 64; return h * 96 + 64 + (i >> 1) + 16 * (i & 1); } };
struct MapUkv { DI int operator()(int n) const { if (n < 512) { const int h = n >> 6, d = n & 63; return h * 128 + d; } const int m = n - 512, h = m >> 6, d = m & 63; return h * 128 + 64 + d; } };

DI void prologue(const Params& P, long gtid, long gthreads, LAS unsigned char* lds) {
    unsigned char* ws = P.ws;
    const int lane = (int)(gtid & 63), gwv = (int)(gtid >> 6), ngwv = (int)(gthreads >> 6);
    LAS float* scr = (LAS float*)lds + ((int)(gtid >> 6) & 7) * (64 * 65);
    for (int e = 0; e < 2; ++e) {
        conv_wt(P.in[2] + (size_t)e * 1024 * 1280, 1024, 1280, (bf16*)(ws + WS_EIN) + (size_t)e * 1280 * 1024, 1280, 1024, 0, P.in[1] + e * 1024, MapEin(), scr, lane, gwv, ngwv);
        conv_wt(P.in[6] + (size_t)e * 1024 * 1024, 512, 1024, (bf16*)(ws + WS_EOUT) + (size_t)e * 1024 * 1024, 1024, 1024, 0, nullptr, MapId(), scr, lane, gwv, ngwv);
        const float* wp = P.in[4] + (size_t)e * 4 * 128 * 128; const float* sc = P.in[5] + e * 512; const float* wo = P.in[6] + (size_t)e * 1024 * 1024; bf16* bt = (bf16*)(ws + WS_EOUT) + (size_t)e * 1024 * 1024;
        for (long it = gtid; it < 1024 * 64; it += gthreads) {
            const int n = (int)(it & 1023), kk0 = (int)(it >> 10) * 8, g = kk0 >> 7;
            float acc[8];
#pragma unroll
            for (int q = 0; q < 8; ++q) acc[q] = 0.f;
            for (int j = 0; j < 128; ++j) {
                const float wv = wo[(size_t)(512 + g * 128 + j) * 1024 + n] * sc[g * 128 + j];
#pragma unroll
                for (int q = 0; q < 8; ++q) acc[q] += wp[(size_t)(g * 128 + ((kk0 + q) & 127)) * 128 + j] * wv;
            }
            *(u32x4*)(bt + (size_t)n * 1024 + 512 + kk0) = pack8(acc);
        }
    }
    for (int o = 0; o < 2; ++o) {
        conv_wt(P.in[8] + (size_t)o * 1024 * 1440, 1024, 1440, (bf16*)(ws + WS_OIN) + (size_t)o * 1536 * 1024, 1536, 1024, 0, P.in[7] + o * 1024, MapOin(), scr, lane, gwv, ngwv);
        conv_wt(P.in[10] + (size_t)o * 256 * 768, 256, 768, (bf16*)(ws + WS_UQ) + (size_t)o * 768 * 256, 768, 256, 0, P.in[9] + o * 256, MapUq(), scr, lane, gwv, ngwv);
        conv_wt(P.in[12] + (size_t)o * 128 * 1024, 128, 1024, (bf16*)(ws + WS_UKV) + (size_t)o * 1024 * 128, 1024, 128, 0, P.in[11] + o * 128, MapUkv(), scr, lane, gwv, ngwv);
        conv_wt(P.in[20] + (size_t)o * 1024 * 1024, 1024, 1024, (bf16*)(ws + WS_OOUT) + (size_t)o * 1024 * 1024, 1024, 1024, 0, nullptr, MapId(), scr, lane, gwv, ngwv);
    }
    for (int l = 0; l < DEPTH; ++l) {
        conv_wt(P.in[22] + (size_t)l * 1024 * 4096, 1024, 4096, (bf16*)(ws + WS_M1) + (size_t)l * 4096 * 1024, 4096, 1024, 0, P.in[21] + l * 1024, MapId(), scr, lane, gwv, ngwv);
        conv_wt(P.in[23] + (size_t)l * 4096 * 1024, 4096, 1024, (bf16*)(ws + WS_M2) + (size_t)l * 4096 * 1024, 1024, 4096, 0, nullptr, MapId(), scr, lane, gwv, ngwv);
    }
    for (long it = gtid; it < 2 * 8 * 4 * 64 * 8; it += gthreads) {
        const int j = (int)(it & 63), ic = (int)(it >> 6) & 7, g = (int)(it >> 9) & 3, n = (int)(it >> 11) & 7, o = (int)(it >> 14);
        const float* src = ((g & 1) ? P.in[17] : P.in[15]) + (size_t)(((o * 2 + (g >> 1)) * 8 + n)) * 4096;
        float v[8];
#pragma unroll
        for (int q = 0; q < 8; ++q) v[q] = src[(ic * 8 + q) * 64 + j];
        *(u32x4*)((bf16*)(ws + WS_WG) + (size_t)(((o * 8 + n) * 4 + g)) * 4096 + j * 64 + ic * 8) = pack8(v);
    }
    for (long it = gtid; it < 2 * 2 * 512; it += gthreads) ((float*)(ws + WS_SP))[it] = log1pf(expf(-P.in[19][it]));
    float* ca = (float*)(ws + WS_ROPA); float* sa = ca + SEQ * 32; float* cc = (float*)(ws + WS_ROPC); float* sc2 = cc + SEQ * 16;
    for (long it = gtid; it < (long)SEQ * 32; it += gthreads) {
        const int pos = (int)(it >> 5), p = (int)(it & 31);
        const float inv = powf(10000.f, -(float)p / 32.f); float s, c; sincos_acc((float)pos * inv, s, c); ca[it] = c; sa[it] = s;
    }
    for (long it = gtid; it < (long)SEQ * 16; it += gthreads) {
        const int pos = (int)(it >> 4), p = (int)(it & 15);
        const float inv = powf(10000.f, -(float)p / 16.f); float s, c; sincos_acc((float)pos * inv, s, c); cc[it] = c; sc2[it] = s;
    }
    const long gw = gtid >> 6, ngw = gthreads >> 6;
    bf16* xb = (bf16*)(ws + WS_XB); float* ssp = (float*)(ws + WS_SSP);
    for (long row = gw; row < MTOK; row += ngw) {
        const f32x4* xr = (const f32x4*)(P.in[0] + (size_t)row * DM) + lane; float s = 0.f;
#pragma unroll
        for (int j = 0; j < 4; ++j) { const f32x4 v = xr[64 * j]; s += (v.x * v.x + v.y * v.y) + (v.z * v.z + v.w * v.w);
            u32x2 w; w.x = cvtpk(v.x, v.y); w.y = cvtpk(v.z, v.w); *((u32x2*)(xb + (size_t)row * DM) + lane + 64 * j) = w; }
#pragma unroll
        for (int o = 1; o < 64; o <<= 1) s += __shfl_xor(s, o);
        if (lane < 4) ssp[row * 4 + lane] = (lane == 0) ? s : 0.f;
    }
}

#define GAS __attribute__((address_space(1)))
template <int NP> DI float row_rstd(const float* part, int row, float inv_n) {
    float s;
    if (NP == 16) { const f32x4* p = (const f32x4*)(part + (size_t)row * 16); const f32x4 a = p[0], b = p[1], c = p[2], d = p[3]; s = ((a.x + a.y) + (a.z + a.w)) + ((b.x + b.y) + (b.z + b.w)) + ((c.x + c.y) + (c.z + c.w)) + ((d.x + d.y) + (d.z + d.w)); }
    else { const f32x4 a = *(const f32x4*)(part + (size_t)row * 4); s = (a.x + a.y) + (a.z + a.w); }
    return rsqrtf(s * inv_n + EPS);
}
DI float row_rstd4g(GAS const float* part, int row, float inv_n) { const f32x4 a = *(GAS const f32x4*)(part + (size_t)row * 4); return rsqrtf(((a.x + a.y) + (a.z + a.w)) * inv_n + EPS); }
enum { EPI_EIN = 0, EPI_RES = 1, EPI_MLP1 = 2, EPI_OIN = 3, EPI_UQ = 4, EPI_UKV = 5 };
template <int MODE> struct Epi {
    static constexpr bool PERM = true, AFTER_DRAIN = false;
    GAS const float* ssin;
    GAS const float* xold; GAS float* xnew; GAS bf16* xb; GAS float* ssout;
    GAS unsigned char* ws;
    LAS unsigned char* ldsbase;
    DI void rope4(float (&v)[8], GAS const float* ct, GAS const float* st, int pos, int half, int p0) const {
        const f32x4 cs = *(GAS const f32x4*)(ct + (size_t)pos * half + p0), sn = *(GAS const f32x4*)(st + (size_t)pos * half + p0);
#pragma unroll
        for (int j = 0; j < 4; ++j) { const float x1 = v[2 * j], x2 = v[2 * j + 1]; v[2 * j] = x1 * cs[j] - x2 * sn[j]; v[2 * j + 1] = x2 * cs[j] + x1 * sn[j]; }
    }
    DI void operator()(const pg8::f32x4 (&acc)[2][2][4][2], const pg8::Unit& u, int wr, int wc, int fr, int fq) const {
        const int row0 = u.pm * 256 + wr * 64 + fr, colb = u.pn * 256 + wc * 32 + 8 * fq;
        LAS float* ssl = (LAS float*)(ldsbase + 131072);
        float rsv[2][4];
#pragma unroll
        for (int ai = 0; ai < 2; ++ai)
#pragma unroll
            for (int m = 0; m < 4; ++m) {
                const int row = row0 + ai * 128 + m * 16; float rs = 1.f;
                if (MODE == EPI_EIN || MODE == EPI_MLP1 || MODE == EPI_OIN) rs = row_rstd4g(ssin, row, 1.f / 1024.f);
                if (MODE == EPI_UQ) rs = row_rstd4g(ssin, row, 1.f / 256.f);
                if (MODE == EPI_UKV) rs = row_rstd4g(ssin, row, 1.f / 128.f);
                rsv[ai][m] = rs; }
        u32x4 resid[2][4][2];
        if (MODE == EPI_RES) {
#pragma unroll
            for (int ai = 0; ai < 2; ++ai)
#pragma unroll
                for (int m = 0; m < 4; ++m)
#pragma unroll
                    for (int bj = 0; bj < 2; ++bj) resid[ai][m][bj] = *(GAS const u32x4*)(xb + (size_t)(row0 + ai * 128 + m * 16) * DM + colb + bj * 128);
        }
#pragma unroll
        for (int ai = 0; ai < 2; ++ai)
#pragma unroll
            for (int m = 0; m < 4; ++m) {
                const int row = row0 + ai * 128 + m * 16; const int pos = row & (SEQ - 1);
                const float rs = rsv[ai][m];
                float sq = 0.f;
#pragma unroll
                for (int bj = 0; bj < 2; ++bj) {
                    const int c = colb + bj * 128;
                    float v[8];
#pragma unroll
                    for (int j = 0; j < 4; ++j) { v[j] = acc[ai][bj][m][0][j] * rs; v[4 + j] = acc[ai][bj][m][1][j] * rs; }
                    if (MODE == EPI_EIN) {
                        GAS bf16* dst;
                        if (c < 640) {
                            rope4(v, (GAS const float*)(ws + WS_ROPA), (GAS const float*)(ws + WS_ROPA) + SEQ * 32, pos, 32, (c & 63) >> 1);
                            if (c < 512) {
#pragma unroll
                                for (int j = 0; j < 8; ++j) v[j] *= QSCALE_A;
                                dst = (GAS bf16*)(ws + WS_Q) + (size_t)row * 512 + c;
                            } else dst = (GAS bf16*)(ws + WS_K) + (size_t)row * 128 + (c - 512);
                        } else if (c < 768) dst = (GAS bf16*)(ws + WS_V) + (size_t)row * 128 + (c - 640);
                        else dst = (GAS bf16*)(ws + WS_U) + (size_t)row * 512 + (c - 768);
                        *(GAS u32x4*)dst = pack8(v);
                    } else if (MODE == EPI_RES) {
                        const size_t off = (size_t)row * DM + c;
                        float xo[8]; unpack8(resid[ai][m][bj], xo);
#pragma unroll
                        for (int j = 0; j < 8; ++j) v[j] += xo[j];
                        const u32x4 pk = pack8(v);
                        *(GAS u32x4*)(xb + off) = pk;
                        unpack8(pk, xo);
#pragma unroll
                        for (int j = 0; j < 8; ++j) sq += xo[j] * xo[j];
                    } else if (MODE == EPI_MLP1) {
#pragma unroll
                        for (int j = 0; j < 8; ++j) { const float t = fmaxf(v[j], 0.f); v[j] = t * t; }
                        __builtin_nontemporal_store(pack8(v), (GAS u32x4*)((GAS bf16*)(ws + WS_H) + (size_t)row * DFF + c));
                    } else if (MODE == EPI_OIN) {
                        if (c < 256) {
                            *(GAS u32x4*)((GAS bf16*)(ws + WS_CQ) + (size_t)row * 256 + c) = pack8(v);
#pragma unroll
                            for (int j = 0; j < 8; ++j) sq += v[j] * v[j];
                        } else if (c < 384) {
                            *(GAS u32x4*)((GAS bf16*)(ws + WS_CKV) + (size_t)row * 128 + (c - 256)) = pack8(v);
#pragma unroll
                            for (int j = 0; j < 8; ++j) sq += v[j] * v[j];
                        } else if (c < 416) {
                            rope4(v, (GAS const float*)(ws + WS_ROPC), (GAS const float*)(ws + WS_ROPC) + SEQ * 16, pos, 16, (c - 384) >> 1);
                            *(GAS u32x4*)((GAS bf16*)(ws + WS_KN) + (size_t)row * KROW + 512 + (c - 384)) = pack8(v);
                        } else if (c < 512) {
                        } else if (c < 1024) {
                            *(GAS u32x4*)((GAS bf16*)(ws + WS_XR) + (size_t)row * 512 + (c - 512)) = pack8(v);
                        } else {
#pragma unroll
                            for (int j = 0; j < 8; ++j) v[j] = gelu_tanh(v[j]);
                            *(GAS u32x4*)((GAS bf16*)(ws + WS_GXG) + (size_t)row * 512 + (c - 1024)) = pack8(v);
                        }
                    } else if (MODE == EPI_UQ) {
                        const int hq = c / 96, w = c - 96 * hq;
                        if (w >= 64) rope4(v, (GAS const float*)(ws + WS_ROPC), (GAS const float*)(ws + WS_ROPC) + SEQ * 16, pos, 16, (w - 64) >> 1);
#pragma unroll
                        for (int j = 0; j < 8; ++j) v[j] *= QSCALE_C;
                        *(GAS u32x4*)((GAS bf16*)(ws + WS_QM) + (size_t)row * 768 + c) = pack8(v);
                    } else if (MODE == EPI_UKV) {
                        GAS bf16* dst = (c < 512) ? (GAS bf16*)(ws + WS_KN) + (size_t)row * KROW + c : (GAS bf16*)(ws + WS_VM) + (size_t)row * 512 + (c - 512);
                        *(GAS u32x4*)dst = pack8(v);
                    }
                }
                if (MODE == EPI_RES) {
                    sq += __shfl_xor(sq, 16); sq += __shfl_xor(sq, 32);
                    if (fq == 0) ssl[(ai * 128 + wr * 64 + m * 16 + fr) * 4 + wc] = sq;
                }
                if (MODE == EPI_OIN) {
                    if (u.pn <= 1) {
                        sq += __shfl_xor(sq, 16); sq += __shfl_xor(sq, 32);
                        if (fq == 0) ((GAS float*)(ws + (u.pn == 0 ? WS_SSQ : WS_SSKV)))[(size_t)row * 4 + wc] = sq;
                    }
                }
            }
        if (MODE == EPI_RES) {
            asm volatile("s_waitcnt lgkmcnt(0)" ::: "memory"); __builtin_amdgcn_s_barrier(); asm volatile("" ::: "memory");
            const int t = (wr * 4 + wc) * 64 + fq * 16 + fr;
            if (t < 256) { const f32x4 p = *(const LAS f32x4*)(ssl + t * 4); ssout[(size_t)(u.pm * 256 + t) * 4 + u.pn] = (p.x + p.y) + (p.z + p.w); }
        }
    }
};

template <int NKS, int KPITCH, bool MASK>
DI void attn_tile(const LAS unsigned char* Kt, const LAS unsigned char* Vt, const bf16x8 (&qf)[NKS], f32x16 (&o)[2], float& m, float& l, int r, int hh, int lane, int kvpos0, int qpos) {
    f32x16 s0, s1;
#pragma unroll
    for (int i = 0; i < 16; ++i) { s0[i] = 0.f; s1[i] = 0.f; }
    const LAS unsigned char* kp = Kt + r * KPITCH + hh * 16;
#pragma unroll
    for (int ks = 0; ks < NKS; ++ks) {
        const bf16x8 a0 = *(const LAS bf16x8*)(kp + ks * 32);
        const bf16x8 a1 = *(const LAS bf16x8*)(kp + 32 * KPITCH + ks * 32);
        s0 = MFMA32(a0, qf[ks], s0); s1 = MFMA32(a1, qf[ks], s1);
    }
    if (MASK) {
#pragma unroll
        for (int i = 0; i < 16; ++i) {
            const int kv = kvpos0 + crow(i, hh), kv1 = kv + 32;
            const int d0 = kv - qpos, d1 = kv1 - qpos;
            if (!(kv >= 0 && kv < SEQ && d0 <= 128 && d0 >= -128)) s0[i] = -1e30f;
            if (!(kv1 >= 0 && kv1 < SEQ && d1 <= 128 && d1 >= -128)) s1[i] = -1e30f;
        }
    }
    float mx = fmaxf(s0[0], s1[0]);
#pragma unroll
    for (int i = 1; i < 16; ++i) mx = fmaxf(mx, fmaxf(s0[i], s1[i]));
    mx = swap_max(mx);
    if (__any(mx > m + 8.f)) {
        const float mn = fmaxf(m, mx); const float al = __builtin_amdgcn_exp2f(m - mn);
        l *= al;
#pragma unroll
        for (int i = 0; i < 16; ++i) { o[0][i] *= al; o[1][i] *= al; }
        m = mn;
    }
    float rs = 0.f;
#pragma unroll
    for (int i = 0; i < 16; ++i) { s0[i] = __builtin_amdgcn_exp2f(s0[i] - m); s1[i] = __builtin_amdgcn_exp2f(s1[i] - m); rs += s0[i] + s1[i]; }
    l += rs;
    bf16x8 pb[2][2];
#pragma unroll
    for (int s = 0; s < 2; ++s) {
        u32x4 w0, w1;
        w0.x = cvtpk(s0[8 * s + 0], s0[8 * s + 1]); w0.y = cvtpk(s0[8 * s + 2], s0[8 * s + 3]); w0.z = cvtpk(s0[8 * s + 4], s0[8 * s + 5]); w0.w = cvtpk(s0[8 * s + 6], s0[8 * s + 7]);
        w1.x = cvtpk(s1[8 * s + 0], s1[8 * s + 1]); w1.y = cvtpk(s1[8 * s + 2], s1[8 * s + 3]); w1.z = cvtpk(s1[8 * s + 4], s1[8 * s + 5]); w1.w = cvtpk(s1[8 * s + 6], s1[8 * s + 7]);
        pb[0][s] = __builtin_bit_cast(bf16x8, w0); pb[1][s] = __builtin_bit_cast(bf16x8, w1);
    }
    const LAS unsigned char* vp = Vt + (4 * hh + ((lane & 15) >> 2)) * 64 + ((lane >> 4) & 1) * 32 + (lane & 3) * 8;
#pragma unroll
    for (int db = 0; db < 2; ++db)
#pragma unroll
        for (int kvh = 0; kvh < 2; ++kvh)
#pragma unroll
            for (int s = 0; s < 2; ++s) {
                const s16x4 lo = vtr(vp + db * 4096 + (32 * kvh + 16 * s) * 64), hi = vtr(vp + db * 4096 + (32 * kvh + 16 * s + 8) * 64);
                const bf16x8 vf = __builtin_shufflevector(lo, hi, 0, 1, 2, 3, 4, 5, 6, 7);
                o[db] = MFMA32(vf, pb[kvh][s], o[db]);
            }
}
DI void attn_store(const f32x16 (&o)[2], float l, bf16* yrow, int hh) {
    const float inv = 1.f / swap_sum(l);
#pragma unroll
    for (int db = 0; db < 2; ++db)
#pragma unroll
        for (int g4 = 0; g4 < 4; ++g4) {
            u32x2 w; w.x = cvtpk(o[db][4 * g4] * inv, o[db][4 * g4 + 1] * inv); w.y = cvtpk(o[db][4 * g4 + 2] * inv, o[db][4 * g4 + 3] * inv);
            *(u32x2*)(yrow + 32 * db + 8 * g4 + 4 * hh) = w;
        }
}

DI void glds16(const void* gsrc, unsigned lds_dst) { unsigned keep;
    asm volatile("s_mov_b32 %0, m0\n\ts_mov_b32 m0, %2\n\ts_nop 0\n\tglobal_load_lds_dwordx4 %1, off\n\ts_mov_b32 m0, %0" : "=&s"(keep) : "v"(gsrc), "s"(lds_dst) : "memory"); }
DI void mla_unit(const bf16* __restrict__ QM, const bf16* __restrict__ KN, const bf16* __restrict__ KR, const bf16* __restrict__ VM, bf16* __restrict__ Y, int b, int h, int qb, LAS unsigned char* lds, int wv) {
    int tid_ = wv * 64 + lane_id(); asm volatile("" : "+v"(tid_));
    const int tid = tid_, lane = tid & 63, wave = __builtin_amdgcn_readfirstlane(tid >> 6), r = lane & 31, hh = lane >> 5;
    constexpr int KSLOT = 16384, VSLOT = 8192, STG = KSLOT + VSLOT, ND = 4, NT = SEQ / 64;
    const size_t tok0 = (size_t)b * SEQ; const int q0 = qb * 256 + wave * 32;
    const unsigned lds0 = (unsigned)(uintptr_t)lds;
    const __amdgpu_buffer_rsrc_t srdK = __builtin_amdgcn_make_buffer_rsrc((void*)(KN + tok0 * KROW), (short)0, (int)(SEQ * KROW * 2), 0x00020000);
    const __amdgpu_buffer_rsrc_t srdV = __builtin_amdgcn_make_buffer_rsrc((void*)(VM + tok0 * 512), (short)0, (int)(SEQ * 1024), 0x00020000);
    unsigned vk0, vk1, vv0;
    {   const int pos = lane & 15, row0 = 4 * wave + (lane >> 4);
        int c_ = pos ^ (row0 & 15);
        if (c_ >= 12) c_ = 0;
        const unsigned goff = (c_ < 8) ? (unsigned)(h * 128 + c_ * 16) : (unsigned)(1024 + (c_ - 8) * 16);
        vk0 = (unsigned)row0 * (KROW * 2) + goff; vk1 = vk0 + 32u * (KROW * 2);
        vv0 = (unsigned)(16 * (wave & 3) + (lane >> 2)) * 1024u + (unsigned)(h * 128 + ((wave >> 2) * 4 + (lane & 3)) * 16); }
    const unsigned dk0 = lds0 + wave * 1024, dk1 = lds0 + (8 + wave) * 1024, dv0 = lds0 + KSLOT + wave * 1024;
#define BGLDS(VOFF, SRD, SOFF, M0V) asm volatile("s_mov_b32 m0, %0\n\ts_nop 0\n\tbuffer_load_dwordx4 %1, %2, %3 offen lds" :: "s"(M0V), "v"(VOFF), "s"(SRD), "s"(SOFF) : "m0", "memory")
#define MLA_ISSUE(J) do { const int j_ = (J); const int kt_ = (j_ + 1 < NT) ? j_ + 1 : NT - 1, vt_ = (j_ < 0) ? 0 : ((j_ < NT) ? j_ : NT - 1); \
        const unsigned so_ = (unsigned)(((j_ + ND) % ND) * STG); const unsigned ks_ = (unsigned)kt_ * (64u * KROW * 2u), vs_ = (unsigned)vt_ * (64u * 1024u); \
        BGLDS(vk0, srdK, ks_, (unsigned)__builtin_amdgcn_readfirstlane(dk0 + so_)); \
        BGLDS(vk1, srdK, ks_, (unsigned)__builtin_amdgcn_readfirstlane(dk1 + so_)); \
        BGLDS(vv0, srdV, vs_, (unsigned)__builtin_amdgcn_readfirstlane(dv0 + so_)); } while (0)
    MLA_ISSUE(-1); MLA_ISSUE(0); MLA_ISSUE(1); MLA_ISSUE(2);
    bf16x8 qf[6];
#pragma unroll
    for (int ks = 0; ks < 6; ++ks) qf[ks] = *(const bf16x8*)(QM + (tok0 + q0 + r) * 768 + h * 96 + ks * 16 + hh * 8);
    asm volatile("" : "+v"(qf[0]), "+v"(qf[1]), "+v"(qf[2]), "+v"(qf[3]), "+v"(qf[4]), "+v"(qf[5]));
    asm volatile("s_waitcnt vmcnt(0)\n\ts_barrier" ::: "memory");
    const int krow = r * 256, ky = (hh ^ (r & 15)) << 4;
    int kpo[6];
#pragma unroll
    for (int ks = 0; ks < 6; ++ks) kpo[ks] = (32 * ks) ^ ky;
    const int vro = KSLOT + (4 * hh + ((lane & 15) >> 2)) * 64 + ((lane >> 4) & 1) * 32 + (lane & 3) * 8;
    f32x16 c0, c1, o[2], negm;
#pragma unroll
    for (int i = 0; i < 16; ++i) { c0[i] = 0.f; c1[i] = 0.f; o[0][i] = 0.f; o[1][i] = 0.f; }
    {   const LAS unsigned char* kb = lds + (ND - 1) * STG + krow;
#pragma unroll
        for (int ks = 0; ks < 6; ++ks) {
            const int po = (32 * ks) ^ ky;
            const bf16x8 a0 = *(const LAS bf16x8*)(kb + po), a1 = *(const LAS bf16x8*)(kb + 32 * 256 + po);
            c0 = MFMA32(a0, qf[ks], c0); c1 = MFMA32(a1, qf[ks], c1);
        } }
    float m, l = 0.f;
    { float mx = fmaxf(c0[0], c1[0]);
#pragma unroll
      for (int i = 1; i < 16; ++i) mx = fmaxf(mx, fmaxf(c0[i], c1[i]));
      m = swap_max(mx);
#pragma unroll
      for (int i = 0; i < 16; ++i) { c0[i] -= m; c1[i] -= m; negm[i] = -m; } }
    asm volatile("s_waitcnt lgkmcnt(0)\n\ts_barrier" ::: "memory");
#define SB() __builtin_amdgcn_sched_barrier(0)
#define KLD(ks) do { ka[ks] = *(const LAS bf16x8*)(kb + kpo[ks]); kc[ks] = *(const LAS bf16x8*)(kb + 32 * 256 + kpo[ks]); } while (0)
#define EXO(C0, C1, i) do { C0[i] = __builtin_amdgcn_exp2f(C0[i]); C1[i] = __builtin_amdgcn_exp2f(C1[i]); } while (0)
#define ADS(C0, C1, i) do { rsum += C0[i]; rsum += C1[i]; } while (0)
#define PCK(kvh, s, c) do { u32x4 w_; w_.x = cvtpk(c[8 * s + 0], c[8 * s + 1]); w_.y = cvtpk(c[8 * s + 2], c[8 * s + 3]); w_.z = cvtpk(c[8 * s + 4], c[8 * s + 5]); w_.w = cvtpk(c[8 * s + 6], c[8 * s + 7]); pb[kvh][s] = __builtin_bit_cast(bf16x8, w_); } while (0)
#define VLD(j) do { const int o_ = ((j) & 1) * 4096 + (((j) >> 1) * 16) * 64; vlo[(j) & 3] = vtr(vc + o_); vhi[(j) & 3] = vtr(vc + o_ + 8 * 64); } while (0)
#define PVM(j) do { o[(j) & 1] = MFMA32(__builtin_shufflevector(vlo[(j) & 3], vhi[(j) & 3], 0, 1, 2, 3, 4, 5, 6, 7), pb[(j) >> 2][((j) >> 1) & 1], o[(j) & 1]); } while (0)
#define MX4(N0, N1, i) do { mi = max(max(mi, __float_as_int(N0[i])), __float_as_int(N1[i])); mi = max(max(mi, __float_as_int(N0[i + 1])), __float_as_int(N1[i + 1])); } while (0)
#define MLA_BODY(T, C0, C1, N0, N1) do { const int t = (T); \
        MLA_ISSUE(t + ND - 1);                                                  \
        const LAS unsigned char* sb = lds + (t % ND) * STG; \
        const LAS unsigned char* kb = sb + krow; \
        const LAS unsigned char* vc = sb + vro; \
        bf16x8 ka[6], kc[6], pb[2][2]; s16x4 vlo[4], vhi[4]; float rsum = 0.f; \
        KLD(0); KLD(1); KLD(2); SB(); \
        N0 = MFMA32(ka[0], qf[0], negm); N1 = MFMA32(kc[0], qf[0], negm); KLD(3); EXO(C0, C1, 0); EXO(C0, C1, 1); EXO(C0, C1, 2); SB(); \
        N0 = MFMA32(ka[1], qf[1], N0); N1 = MFMA32(kc[1], qf[1], N1); KLD(4); EXO(C0, C1, 3); EXO(C0, C1, 4); EXO(C0, C1, 5); ADS(C0, C1, 0); ADS(C0, C1, 1); ADS(C0, C1, 2); SB(); \
        N0 = MFMA32(ka[2], qf[2], N0); N1 = MFMA32(kc[2], qf[2], N1); KLD(5); EXO(C0, C1, 6); EXO(C0, C1, 7); ADS(C0, C1, 3); ADS(C0, C1, 4); ADS(C0, C1, 5); SB(); \
        N0 = MFMA32(ka[3], qf[3], N0); N1 = MFMA32(kc[3], qf[3], N1); VLD(0); VLD(1); EXO(C0, C1, 8); EXO(C0, C1, 9); EXO(C0, C1, 10); ADS(C0, C1, 6); ADS(C0, C1, 7); PCK(0, 0, C0); PCK(1, 0, C1); SB(); \
        N0 = MFMA32(ka[4], qf[4], N0); N1 = MFMA32(kc[4], qf[4], N1); VLD(2); VLD(3); EXO(C0, C1, 11); EXO(C0, C1, 12); EXO(C0, C1, 13); ADS(C0, C1, 8); ADS(C0, C1, 9); ADS(C0, C1, 10); SB(); \
        N0 = MFMA32(ka[5], qf[5], N0); N1 = MFMA32(kc[5], qf[5], N1); EXO(C0, C1, 14); EXO(C0, C1, 15); ADS(C0, C1, 11); ADS(C0, C1, 12); ADS(C0, C1, 13); SB(); \
        ADS(C0, C1, 14); ADS(C0, C1, 15); PCK(0, 1, C0); PCK(1, 1, C1); l += rsum; \
        int mi = (int)0x80000000; \
        PVM(0); VLD(4); SB(); \
        PVM(1); VLD(5); SB(); \
        PVM(2); VLD(6); MX4(N0, N1, 0); SB(); \
        PVM(3); VLD(7); MX4(N0, N1, 2); SB(); \
        PVM(4); MX4(N0, N1, 4); MX4(N0, N1, 6); SB(); \
        PVM(5); MX4(N0, N1, 8); MX4(N0, N1, 10); SB(); \
        PVM(6); MX4(N0, N1, 12); SB(); \
        PVM(7); MX4(N0, N1, 14); SB(); \
        { auto rr_ = __builtin_amdgcn_permlane32_swap((unsigned)mi, (unsigned)mi, false, false); mi = max((int)rr_[0], (int)rr_[1]); } \
        if (__any(mi > 0x41000000)) {          \
            const float mx = __int_as_float(mi); const float dl = fmaxf(mx, 0.f), f = __builtin_amdgcn_exp2f(-dl); \
            m += dl; l *= f; \
            _Pragma("unroll") for (int i = 0; i < 16; ++i) { N0[i] -= dl; N1[i] -= dl; negm[i] = -m; o[0][i] *= f; o[1][i] *= f; } \
        } \
          \
        asm volatile("s_waitcnt vmcnt(6) lgkmcnt(0)\n\ts_barrier" ::: "memory"); } while (0)
    f32x16 d0, d1;
    static_assert((NT - 1) % 2 == 1, "one peeled iteration, then pairs");
    if (wave >= 4) __builtin_amdgcn_s_setprio(1);
    MLA_BODY(0, c0, c1, d0, d1);
    asm volatile(".p2align 6" ::: "memory");
    for (int t2 = 1; t2 < NT - 1; t2 += 2) { MLA_BODY(t2, d0, d1, c0, c1); MLA_BODY(t2 + 1, c0, c1, d0, d1); }
    c0 = d0; c1 = d1;
    __builtin_amdgcn_s_setprio(0);
#undef MLA_BODY
#undef KLD
#undef EXO
#undef ADS
#undef PCK
#undef VLD
#undef PVM
#undef MX4
#undef SB
    {
        const LAS unsigned char* vc = lds + ((NT - 1) % ND) * STG + vro;
        float rs0 = 0.f, rs1 = 0.f;
#pragma unroll
        for (int i = 0; i < 16; ++i) { c0[i] = __builtin_amdgcn_exp2f(c0[i]); c1[i] = __builtin_amdgcn_exp2f(c1[i]); rs0 += c0[i]; rs1 += c1[i]; }
        l += rs0 + rs1;
#pragma unroll
        for (int db = 0; db < 2; ++db)
#pragma unroll
            for (int kvh = 0; kvh < 2; ++kvh)
#pragma unroll
                for (int s = 0; s < 2; ++s) {
                    u32x4 w; const f32x16& c = kvh ? c1 : c0;
                    w.x = cvtpk(c[8 * s + 0], c[8 * s + 1]); w.y = cvtpk(c[8 * s + 2], c[8 * s + 3]); w.z = cvtpk(c[8 * s + 4], c[8 * s + 5]); w.w = cvtpk(c[8 * s + 6], c[8 * s + 7]);
                    const s16x4 lo = vtr(vc + db * 4096 + (32 * kvh + 16 * s) * 64), hi = vtr(vc + db * 4096 + (32 * kvh + 16 * s + 8) * 64);
                    o[db] = MFMA32(__builtin_shufflevector(lo, hi, 0, 1, 2, 3, 4, 5, 6, 7), __builtin_bit_cast(bf16x8, w), o[db]);
                }
    }
#undef MLA_ISSUE
#undef BGLDS
    attn_store(o, l, Y + (tok0 + q0 + r) * 1024 + h * 64, hh);
    asm volatile("s_waitcnt vmcnt(0) lgkmcnt(0)\n\ts_barrier" ::: "memory");
}

DI void win_unit(const bf16* __restrict__ Q, const bf16* __restrict__ K, const bf16* __restrict__ V, const float* __restrict__ sink, bf16* __restrict__ Y, int b, int qblk, int g, LAS unsigned char* lds, int wv) {
    int tid_ = wv * 64 + lane_id(); asm volatile("" : "+v"(tid_));
    const int tid = tid_, lane = tid & 63, wave = __builtin_amdgcn_readfirstlane(tid >> 6), r = lane & 31, hh = lane >> 5;
    constexpr int KP = 144, KALL = 320 * KP, VT = 8192;
    const size_t tok0 = (size_t)b * SEQ; const int q0 = qblk * 64, kbase = q0 - 128;
#pragma unroll
    for (int it = 0; it < 5; ++it) {
        const int id = tid + it * 512, row = id >> 3, ch = id & 7, pos = kbase + row;
        u32x4 kk = {0u, 0u, 0u, 0u}, vv = {0u, 0u, 0u, 0u};
        if (pos >= 0 && pos < SEQ) { kk = *(const u32x4*)(K + (tok0 + pos) * 128 + g * 64 + ch * 8); vv = *(const u32x4*)(V + (tok0 + pos) * 128 + g * 64 + ch * 8); }
        *(LAS u32x4*)(lds + row * KP + ch * 16) = kk;
        *(LAS u32x4*)(lds + KALL + (row >> 6) * VT + (ch >> 2) * 4096 + (row & 63) * 64 + (ch & 3) * 16) = vv;
    }
    const int hq = g * 4 + (wave >> 1), qw = q0 + (wave & 1) * 32;
    bf16x8 qf[4];
#pragma unroll
    for (int ks = 0; ks < 4; ++ks) qf[ks] = *(const bf16x8*)(Q + (tok0 + qw + r) * 512 + hq * 64 + ks * 16 + hh * 8);
    __syncthreads();
    float m = sink[hq] * LOG2E, l = (hh == 0) ? 1.f : 0.f; f32x16 o[2];
#pragma unroll
    for (int i = 0; i < 16; ++i) { o[0][i] = 0.f; o[1][i] = 0.f; }
    const bool edge = (qblk == 0) || (qblk == SEQ / 64 - 1);
    for (int t = 0; t < 5; ++t) {
        if (t == 0 || t == 4 || edge) attn_tile<4, KP, true>(lds + t * 64 * KP, lds + KALL + t * VT, qf, o, m, l, r, hh, lane, kbase + 64 * t, qw + r);
        else attn_tile<4, KP, false>(lds + t * 64 * KP, lds + KALL + t * VT, qf, o, m, l, r, hh, lane, kbase + 64 * t, qw + r);
    }
    attn_store(o, l, Y + (tok0 + qw + r) * 1024 + hq * 64, hh);
    __syncthreads();
}

template <int HALF>
DI void pool_rows(const bf16* __restrict__ ub, bf16* __restrict__ yb, int s0) {
    float win[8], own[8][8];
#pragma unroll
    for (int q = 0; q < 8; ++q) win[q] = 0.f;
#pragma unroll
    for (int j = -HALF; j < HALF; ++j) { const int ss = s0 + j; u32x4 raw = {0u, 0u, 0u, 0u}; if (ss >= 0 && ss < SEQ) raw = *(const u32x4*)(ub + (size_t)ss * 512);
        float v[8]; unpack8(raw, v);
#pragma unroll
        for (int q = 0; q < 8; ++q) win[q] += v[q];
        if (j >= 0 && j < 8) {
#pragma unroll
            for (int q = 0; q < 8; ++q) own[j][q] = v[q]; } }
    if (HALF < 8) {
#pragma unroll
        for (int j = HALF; j < 8; ++j) { float v[8]; unpack8(*(const u32x4*)(ub + (size_t)(s0 + j) * 512), v);
#pragma unroll
            for (int q = 0; q < 8; ++q) own[j][q] = v[q]; } }
#pragma unroll
    for (int tt = 0; tt < 8; ++tt) {
        const int s = s0 + tt, lo = (s - HALF) < 0 ? 0 : (s - HALF), hi = (s + HALF) > SEQ ? SEQ : (s + HALF);
        const float ic = 1.f / (float)(hi - lo);
        float d[8];
#pragma unroll
        for (int q = 0; q < 8; ++q) d[q] = win[q] * ic - own[tt][q];
        *(u32x4*)(yb + (size_t)s * 1024) = pack8(d);
        if (tt < 7) {
            const int se = s + HALF, sl = s - HALF;
            u32x4 re = {0u, 0u, 0u, 0u}, rl = {0u, 0u, 0u, 0u};
            if (se < SEQ) re = *(const u32x4*)(ub + (size_t)se * 512);
            if (sl >= 0) rl = *(const u32x4*)(ub + (size_t)sl * 512);
            float ve[8], vl[8]; unpack8(re, ve); unpack8(rl, vl);
#pragma unroll
            for (int q = 0; q < 8; ++q) win[q] += ve[q] - vl[q];
        }
    }
}
DI void pool_unit(const bf16* __restrict__ U, bf16* __restrict__ Y, int unit, int wv) {
    int tid_ = wv * 64 + lane_id(); asm volatile("" : "+v"(tid_));
    const int tid = tid_, lane = tid & 63, wave = __builtin_amdgcn_readfirstlane(tid >> 6), g = wave >> 1, lp = (wave & 1) * 64 + lane, cgi = lp & 15, tsub = lp >> 4;
    const int tokbase = unit * 64 + tsub * 8, b = tokbase / SEQ, s0 = tokbase & (SEQ - 1), ch = g * 128 + cgi * 8;
    const bf16* ub = U + (size_t)b * SEQ * 512 + ch; bf16* yb = Y + (size_t)b * SEQ * 1024 + 512 + ch;
    if (g == 0) pool_rows<1>(ub, yb, s0); else if (g == 1) pool_rows<2>(ub, yb, s0); else if (g == 2) pool_rows<4>(ub, yb, s0); else pool_rows<8>(ub, yb, s0);
}

template <int CTRL, int ROWMASK> DI float dppf(float old, float src) { return __int_as_float(__builtin_amdgcn_update_dpp(__float_as_int(old), __float_as_int(src), CTRL, ROWMASK, 0xF, false)); }
DI float rdlane(float v, int l) { return __int_as_float(__builtin_amdgcn_readlane(__float_as_int(v), l)); }
DI float sigm_fast(float x) { return __builtin_amdgcn_rcpf(1.f + __expf(-x)); }
DI void scan_fwd(float& a, float& b) {
#define SCF(D) { const float ap = dppf<0x110 + D, 0xF>(1.f, a), bp = dppf<0x110 + D, 0xF>(0.f, b); b = a * bp + b; a = a * ap; }
    SCF(1) SCF(2) SCF(4) SCF(8)
#undef SCF
    { const float ap = dppf<0x142, 0xA>(1.f, a), bp = dppf<0x142, 0xA>(0.f, b); b = a * bp + b; a = a * ap; }
}
DI void scan_bwd(float& a, float& b, bool lowrow, bool hi) {
#define SCB(D) { const float an = dppf<0x100 + D, 0xF>(1.f, a), bn = dppf<0x100 + D, 0xF>(0.f, b); b = a * bn + b; a = a * an; }
    SCB(1) SCB(2) SCB(4) SCB(8)
#undef SCB
    { const float a16 = rdlane(a, 16), a48 = rdlane(a, 48), b16 = rdlane(b, 16), b48 = rdlane(b, 48);
      const float an = lowrow ? (hi ? a48 : a16) : 1.f, bn = lowrow ? (hi ? b48 : b16) : 0.f; b = a * bn + b; a = a * an; }
}
DI void lru_ab(float pa, float px, float ba, float bx, float sp, float xcv, float& a, float& bb) {
    const float rg = sigm_fast(pa + ba), ig = sigm_fast(px + bx);
    const float la = -8.f * rg * sp; a = __expf(la);
    const float om = fmaxf(1.f - a * a, 0.f);
    bb = __builtin_amdgcn_sqrtf(om) * (ig * xcv);
}
template <int MODE>
DI void lru_phase(const Params& P, int o, LAS unsigned char* lds, int wv, int bx, int G) {
    int tid_ = wv * 64 + lane_id(); asm volatile("" : "+v"(tid_));
    const int tid = tid_, lane = tid & 63, wave = __builtin_amdgcn_readfirstlane(tid >> 6), r = lane & 31, hh = lane >> 5;
    unsigned char* ws = P.ws;
    LAS unsigned char* WG = lds; LAS float* PRM = (LAS float*)(lds + 36864); LAS float* CAR = (LAS float*)(lds + 40960); LAS float* SEG = (LAS float*)(lds + 45056);
    LAS float* XC = (LAS float*)(lds + 53248) + wave * (32 * 65);
    const bf16* XR = (const bf16*)(ws + WS_XR); const bf16* GXG = (const bf16*)(ws + WS_GXG); bf16* Y = (bf16*)(ws + WS_Y);
    f32x2* SUM = (f32x2*)(ws + WS_SUM); f32x2* CSUM = (f32x2*)(ws + WS_CSUM);
    const int n = bx & 7;
    {
        const bf16* wg = (const bf16*)(ws + WS_WG) + (size_t)((o * 8 + n) * 4) * 4096;
#pragma unroll
        for (int it = 0; it < 4; ++it) { const int q = tid + it * 512, g = q >> 9, rem = q & 511, j = rem >> 3, ch = rem & 7;
            *(LAS u32x4*)(WG + (g * 64 + j) * 144 + ch * 16) = *(const u32x4*)(wg + g * 4096 + j * 64 + ch * 8); }
        for (int q = tid; q < 11 * 64; q += 512) {
            const int k = q >> 6, chl = q & 63, ch = 64 * n + chl; float v;
            if (k == 0) v = P.in[16][(o * 2 + 0) * 512 + ch]; else if (k == 1) v = P.in[18][(o * 2 + 0) * 512 + ch];
            else if (k == 2) v = P.in[16][(o * 2 + 1) * 512 + ch]; else if (k == 3) v = P.in[18][(o * 2 + 1) * 512 + ch];
            else if (k < 6) v = ((const float*)(ws + WS_SP))[(o * 2 + (k - 4)) * 512 + ch];
            else if (k < 10) v = P.in[13][(size_t)(o * 4 + (k - 6)) * 512 + ch];
            else v = P.in[14][o * 512 + ch];
            PRM[k * 64 + chl] = v;
        }
    }
    __syncthreads();
    for (int u = bx; u < 2 * 64 * 8; u += G) {
        const int c = (u >> 3) & 63, b = u >> 9;
        if (MODE == 1) {
            if (wave == 6) {
                const f32x2* cs = CSUM + (size_t)((0 * 2 + b) * 64) * 512 + 64 * n + lane; float cf = 0.f;
                for (int cc0 = 0; cc0 < c; cc0 += 8) {
                    f32x2 ab[8];
#pragma unroll
                    for (int j = 0; j < 8; ++j) { const int cc = cc0 + j; ab[j] = cs[(size_t)(cc < c ? cc : 0) * 512]; }
#pragma unroll
                    for (int j = 0; j < 8; ++j) if (cc0 + j < c) cf = ab[j].x * cf + ab[j].y;
                }
                const f32x2* ss = SUM + (size_t)((0 * 2 + b) * 512 + 8 * c) * 512 + 64 * n + lane;
                { f32x2 ab[8];
#pragma unroll
                  for (int w = 0; w < 8; ++w) ab[w] = ss[(size_t)w * 512];
#pragma unroll
                  for (int w = 0; w < 8; ++w) { CAR[w * 64 + lane] = cf; cf = ab[w].x * cf + ab[w].y; } }
            } else if (wave == 7) {
                const f32x2* cs = CSUM + (size_t)((1 * 2 + b) * 64) * 512 + 64 * n + lane; float cb = 0.f;
                for (int cc0 = 63; cc0 > c; cc0 -= 8) {
                    f32x2 ab[8];
#pragma unroll
                    for (int j = 0; j < 8; ++j) { const int cc = cc0 - j; ab[j] = cs[(size_t)(cc > c ? cc : 63) * 512]; }
#pragma unroll
                    for (int j = 0; j < 8; ++j) if (cc0 - j > c) cb = ab[j].x * cb + ab[j].y;
                }
                const f32x2* ss = SUM + (size_t)((1 * 2 + b) * 512 + 8 * c) * 512 + 64 * n + lane;
                { f32x2 ab[8];
#pragma unroll
                  for (int w = 0; w < 8; ++w) ab[w] = ss[(size_t)w * 512];
#pragma unroll
                  for (int w = 7; w >= 0; --w) { CAR[512 + w * 64 + lane] = cb; cb = ab[w].x * cb + ab[w].y; } }
            }
        }
        const int t = c * 256 + wave * 32 + r; const size_t brow = (size_t)b * SEQ;
        bf16x8 bfrag[4];
#pragma unroll
        for (int ks = 0; ks < 4; ++ks) {
            const int chl0 = 16 * ks + 8 * hh, ch0 = 64 * n + chl0;
            float xc[8];
            { const f32x4 b0 = *(const LAS f32x4*)(PRM + 10 * 64 + chl0), b1 = *(const LAS f32x4*)(PRM + 10 * 64 + chl0 + 4);
#pragma unroll
              for (int q = 0; q < 4; ++q) { xc[q] = b0[q]; xc[4 + q] = b1[q]; } }
#pragma unroll
            for (int j = 0; j < 4; ++j) {
                const int tt = t + j - 2;
                u32x4 raw = {0u, 0u, 0u, 0u};
                if (tt >= 0 && tt < SEQ) raw = *(const u32x4*)(XR + (brow + tt) * 512 + ch0);
                float xv[8]; unpack8(raw, xv);
                const f32x4 w0 = *(const LAS f32x4*)(PRM + (6 + j) * 64 + chl0), w1 = *(const LAS f32x4*)(PRM + (6 + j) * 64 + chl0 + 4);
#pragma unroll
                for (int q = 0; q < 4; ++q) { xc[q] += w0[q] * xv[q]; xc[4 + q] += w1[q] * xv[4 + q]; }
            }
#pragma unroll
            for (int q = 0; q < 8; ++q) XC[r * 65 + chl0 + q] = xc[q];
            bfrag[ks] = __builtin_bit_cast(bf16x8, pack8(xc));
        }
        if (MODE == 1) __syncthreads();
        f32x16 acc[4][2];
#pragma unroll
        for (int g = 0; g < 4; ++g)
#pragma unroll
            for (int hf = 0; hf < 2; ++hf) {
                f32x16 a;
#pragma unroll
                for (int i = 0; i < 16; ++i) a[i] = 0.f;
#pragma unroll
                for (int ks = 0; ks < 4; ++ks) { const bf16x8 wf = *(const LAS bf16x8*)(WG + (g * 64 + 32 * hf + r) * 144 + (16 * ks + 8 * hh) * 2); a = MFMA32(bfrag[ks], wf, a); }
                acc[g][hf] = a;
            }
        const size_t mrow0 = brow + c * 256 + wave * 32;
#pragma unroll
        for (int hf = 0; hf < 2; ++hf) {
            const int chl = 32 * hf + r;
            const float ba0 = PRM[0 * 64 + chl], bx0 = PRM[1 * 64 + chl], ba1 = PRM[2 * 64 + chl], bx1 = PRM[3 * 64 + chl], sp0 = PRM[4 * 64 + chl], sp1 = PRM[5 * 64 + chl];
            const LAS float* xcl = XC + (4 * hh) * 65 + chl;
            float PF[16], HF[16], PB[16], HB[16];
#pragma unroll
            for (int q = 0; q < 4; ++q) {
                float aF[4], bF[4], aB[4], bB[4];
#pragma unroll
                for (int e = 0; e < 4; ++e) { const int i = 4 * q + e; const float xcv = xcl[(e + 8 * q) * 65];
                    lru_ab(acc[0][hf][i], acc[1][hf][i], ba0, bx0, sp0, xcv, aF[e], bF[e]);
                    lru_ab(acc[2][hf][i], acc[3][hf][i], ba1, bx1, sp1, xcv, aB[e], bB[e]); }
                PF[4 * q] = aF[0]; HF[4 * q] = bF[0];
#pragma unroll
                for (int e = 1; e < 4; ++e) { PF[4 * q + e] = aF[e] * PF[4 * q + e - 1]; HF[4 * q + e] = aF[e] * HF[4 * q + e - 1] + bF[e]; }
                PB[4 * q + 3] = aB[3]; HB[4 * q + 3] = bB[3];
#pragma unroll
                for (int e = 2; e >= 0; --e) { PB[4 * q + e] = aB[e] * PB[4 * q + e + 1]; HB[4 * q + e] = aB[e] * HB[4 * q + e + 1] + bB[e]; }
            }
            float GAF[8], GBF[8], GAB[8], GBB[8];
#pragma unroll
            for (int q = 0; q < 4; ++q) {
                { auto rr = __builtin_amdgcn_permlane32_swap(__float_as_uint(PF[4 * q + 3]), __float_as_uint(PF[4 * q + 3]), false, false); GAF[2 * q] = __uint_as_float(rr[0]); GAF[2 * q + 1] = __uint_as_float(rr[1]); }
                { auto rr = __builtin_amdgcn_permlane32_swap(__float_as_uint(HF[4 * q + 3]), __float_as_uint(HF[4 * q + 3]), false, false); GBF[2 * q] = __uint_as_float(rr[0]); GBF[2 * q + 1] = __uint_as_float(rr[1]); }
                { auto rr = __builtin_amdgcn_permlane32_swap(__float_as_uint(PB[4 * q]), __float_as_uint(PB[4 * q]), false, false); GAB[2 * q] = __uint_as_float(rr[0]); GAB[2 * q + 1] = __uint_as_float(rr[1]); }
                { auto rr = __builtin_amdgcn_permlane32_swap(__float_as_uint(HB[4 * q]), __float_as_uint(HB[4 * q]), false, false); GBB[2 * q] = __uint_as_float(rr[0]); GBB[2 * q + 1] = __uint_as_float(rr[1]); }
            }
            if (MODE == 0) {
                float AF = 1.f, BF = 0.f, AB = 1.f, BB = 0.f;
#pragma unroll
                for (int k = 0; k < 8; ++k) { BF = GAF[k] * BF + GBF[k]; AF = GAF[k] * AF; }
#pragma unroll
                for (int k = 7; k >= 0; --k) { BB = GAB[k] * BB + GBB[k]; AB = GAB[k] * AB; }
                if (hh == 0) {
                    SEG[((0 * 8 + wave) * 64 + chl) * 2] = AF; SEG[((0 * 8 + wave) * 64 + chl) * 2 + 1] = BF; SEG[((1 * 8 + wave) * 64 + chl) * 2] = AB; SEG[((1 * 8 + wave) * 64 + chl) * 2 + 1] = BB;
                    SUM[(size_t)((0 * 2 + b) * 512 + 8 * c + wave) * 512 + 64 * n + chl] = (f32x2){AF, BF};
                    SUM[(size_t)((1 * 2 + b) * 512 + 8 * c + wave) * 512 + 64 * n + chl] = (f32x2){AB, BB};
                }
            } else {
                float hin[8], hib[8];
                hin[0] = CAR[wave * 64 + chl];
#pragma unroll
                for (int k = 0; k < 7; ++k) hin[k + 1] = GAF[k] * hin[k] + GBF[k];
                hib[7] = CAR[512 + wave * 64 + chl];
#pragma unroll
                for (int k = 7; k > 0; --k) hib[k - 1] = GAB[k] * hib[k] + GBB[k];
                const bf16* gxp = GXG + (mrow0 + 4 * hh) * 512 + 64 * n + chl; bf16* yp = Y + (mrow0 + 4 * hh) * 1024 + 512 + 64 * n + chl;
#pragma unroll
                for (int q = 0; q < 4; ++q) {
                    const float cf = hh ? hin[2 * q + 1] : hin[2 * q], cb = hh ? hib[2 * q + 1] : hib[2 * q];
#pragma unroll
                    for (int e = 0; e < 4; ++e) { const int i = 4 * q + e, tk = e + 8 * q;
                        const float h = (HF[i] + PF[i] * cf) + (HB[i] + PB[i] * cb);
                        const float gx = __uint_as_float((unsigned)gxp[(size_t)tk * 512] << 16);
                        yp[(size_t)tk * 1024] = (bf16)(cvtpk(h * gx, 0.f) & 0xffffu); }
                }
            }
        }
        if (MODE == 0) {
            __syncthreads();
            if (wave == 0) { float A = 1.f, B = 0.f;
                for (int w = 0; w < 8; ++w) { const float aw = SEG[((0 * 8 + w) * 64 + lane) * 2], bw = SEG[((0 * 8 + w) * 64 + lane) * 2 + 1]; B = aw * B + bw; A = aw * A; }
                CSUM[(size_t)((0 * 2 + b) * 64 + c) * 512 + 64 * n + lane] = (f32x2){A, B};
            } else if (wave == 1) { float A = 1.f, B = 0.f;
                for (int w = 7; w >= 0; --w) { const float aw = SEG[((1 * 8 + w) * 64 + lane) * 2], bw = SEG[((1 * 8 + w) * 64 + lane) * 2 + 1]; B = aw * B + bw; A = aw * A; }
                CSUM[(size_t)((1 * 2 + b) * 64 + c) * 512 + 64 * n + lane] = (f32x2){A, B};
            }
        }
        __syncthreads();
    }
}

#define RLX_AGENT __ATOMIC_RELAXED, __HIP_MEMORY_SCOPE_AGENT
#define XB_TMO      128
#define XB_XCNT(j)  (256  + 64 * (j))
#define XB_XSUB(j)  (1280 + 64 * (j))
#define XB_XGEN(j)  (2304 + 64 * (j))
#define XB_TOP      3328
#define XB_TOPGEN   3392
#define XCD_BAR_WORDS 3456
#define XB_SPIN_CAP (1u << 18)

__device__ __forceinline__ unsigned xb_ld(unsigned* p)              { return __hip_atomic_load(p, __ATOMIC_RELAXED, __HIP_MEMORY_SCOPE_AGENT); }
__device__ __forceinline__ unsigned xb_add(unsigned* p, unsigned v) { return __hip_atomic_fetch_add(p, v, __ATOMIC_RELAXED, __HIP_MEMORY_SCOPE_AGENT); }
__device__ __forceinline__ unsigned xb_xcc_id() { return (unsigned)__builtin_amdgcn_s_getreg((3 << 11) | 20) & 0xFu; }
#define XB_SPIN(cond, bar) do { unsigned _sp = 0; while (cond) { __builtin_amdgcn_s_sleep(1); \
    if ((++_sp & 255u) == 0u) { if (xb_ld(&(bar)[XB_TMO])) break; if (_sp > XB_SPIN_CAP) { atomicAdd(&(bar)[XB_TMO], 1u); break; } } } } while (0)

struct XcdBarrier {
    unsigned* bar; unsigned x; int wv;
    volatile LAS unsigned* st;
};

__device__ __forceinline__ XcdBarrier xcd_barrier_post(unsigned* bar, volatile LAS unsigned* st, int wv) {
    XcdBarrier b; b.bar = bar; b.x = xb_xcc_id(); b.st = st; b.wv = wv;
    if (wv == 0 && lane_id() == 0) (void)xb_add(&bar[XB_XCNT(b.x)], 1u);
    return b;
}
__device__ __forceinline__ void xcd_barrier_complete(unsigned* bar, unsigned x, unsigned& nloc, unsigned& nx) {
    const unsigned G = gridDim.x * gridDim.y * gridDim.z;
    unsigned sum, cnt, mine, sp = 0u;
    for (;;) {
        sum = 0u; cnt = 0u; mine = 0u;
#pragma unroll
        for (unsigned j = 0; j < 16; ++j) { const unsigned c = xb_ld(&bar[XB_XCNT(j)]); sum += c; cnt += (c > 0u) ? 1u : 0u; mine = (j == x) ? c : mine; }
        if (sum == G) break;
        __builtin_amdgcn_s_sleep(1);
        if ((++sp & 255u) == 0u) { if (xb_ld(&bar[XB_TMO])) break; if (sp > XB_SPIN_CAP) { atomicAdd(&bar[XB_TMO], 1u); break; } }
    }
    nloc = mine > 0u ? mine : 1u; nx = cnt > 0u ? cnt : 1u;
}

__device__ __forceinline__ void xcd_barrier(const XcdBarrier& b) {
    asm volatile("s_waitcnt vmcnt(0)" ::: "memory");
    __syncthreads();
    if (b.wv == 0 && lane_id() == 0) {
        unsigned* bar = b.bar;
        __builtin_amdgcn_s_waitcnt(0);
        unsigned nloc = b.st[0], nx = b.st[1];
        if (nloc == 0u) { xcd_barrier_complete(bar, b.x, nloc, nx); b.st[0] = nloc; b.st[1] = nx; }
        const unsigned old = xb_add(&bar[XB_XSUB(b.x)], 1u);
        const unsigned gen = old / nloc;
        if (old + 1u == (gen + 1u) * nloc) {
            __builtin_amdgcn_fence(__ATOMIC_RELEASE, "agent");
            asm volatile("s_waitcnt vmcnt(0)" ::: "memory");
            const unsigned og = xb_add(&bar[XB_TOP], 1u);
            const unsigned tg = og / nx;
            if (og + 1u == (tg + 1u) * nx) xb_add(&bar[XB_TOPGEN], 1u);
            else XB_SPIN(xb_ld(&bar[XB_TOPGEN]) == tg, bar);
            __builtin_amdgcn_fence(__ATOMIC_ACQUIRE, "agent");
            xb_add(&bar[XB_XGEN(b.x)], 1u);
            asm volatile("s_waitcnt vmcnt(0)" ::: "memory");
        } else {
            XB_SPIN(xb_ld(&bar[XB_XGEN(b.x)]) == gen, bar);
            __builtin_amdgcn_fence(__ATOMIC_ACQUIRE, "agent");
            asm volatile("s_waitcnt vmcnt(0)" ::: "memory");
        }
    }
    __syncthreads();
}

template <int MODE> DI void run_gemm(LAS unsigned char* lds, const bf16* A, const bf16* Bt, int N, int K, const Epi<MODE>& E, int G, int wv) {
    pg8::Gemm g{A, Bt, MTOK, N, K, wv}; pg8::StaticOrder S; S.init(MTOK, N, G, (int)blockIdx.x);
    pg8::gemm_phase<Epi<MODE>, pg8::StaticOrder, (MODE == EPI_RES || MODE == EPI_MLP1), true>(lds, g, S, E);
}

__global__ void __launch_bounds__(512, 2) fwd_megakernel(Params P) {
    extern __shared__ __attribute__((aligned(16))) unsigned char lds_raw[];
    LAS unsigned char* lds = (LAS unsigned char*)lds_raw;
    cg::grid_group grid = cg::this_grid();
    const int G = gridDim.x, bx = blockIdx.x;
    const int wv0 = __builtin_amdgcn_readfirstlane((int)threadIdx.x >> 6);
    int tid0_ = wv0 * 64 + lane_id(); asm volatile("" : "+v"(tid0_)); const int tid = tid0_;
    unsigned char* ws = P.ws;
#define WS_FRESH() do { ws = P.ws; asm volatile("" : "+s"(ws)); } while (0)
    const int vcu = (G % 8 == 0) ? (bx % 8) * (G / 8) + bx / 8 : bx;
    volatile LAS unsigned* MISC = (volatile LAS unsigned*)(lds + (LDS_BYTES - 64));
    if (tid < 16) MISC[tid] = 0u;
    __syncthreads();
    XcdBarrier xbar = xcd_barrier_post((unsigned*)(ws + WS_CTL), MISC, wv0);

#if PH & 1
    for (int rep_ = 0; rep_ < PRO_REP; ++rep_)
    prologue(P, (long)bx * 512 + tid, (long)G * 512, lds);
#endif
    grid.sync();
#define GRID_BAR() xcd_barrier(xbar)

    for (int layer = 0; layer < DEPTH; ++layer) {
        const int li = layer >> 1;
        if ((layer & 1) == 0) {
            {   WS_FRESH();
                Epi<EPI_EIN> E{(GAS const float*)(ws + WS_SSP), nullptr, nullptr, nullptr, nullptr, (GAS unsigned char*)ws, lds};
#if PH & 2
                for (int rep_ = 0; rep_ < E1_REP; ++rep_)
                run_gemm<EPI_EIN>(lds, (const bf16*)(ws + WS_XB), (const bf16*)(ws + WS_EIN) + (size_t)li * 1280 * 1024, 1280, 1024, E, G, wv0);
#endif
            }
            GRID_BAR();
            {   WS_FRESH();
                const bf16* Q = (const bf16*)(ws + WS_Q); const bf16* K = (const bf16*)(ws + WS_K); const bf16* V = (const bf16*)(ws + WS_V);
#if PH & 4
                for (int rep_ = 0; rep_ < WIN_REP; ++rep_)
                for (int u = vcu; u < 2 * 256 * 2; u += G) { const int g = u & 1, qblk = (u >> 1) & 255, b = u >> 9; win_unit(Q, K, V, P.in[3] + li * 8, (bf16*)(ws + WS_Y), b, qblk, g, lds, wv0); }
#endif
#if PH & 8
                for (int rep_ = 0; rep_ < WIN_REP; ++rep_)
                for (int u = bx; u < MTOK / 64; u += G) pool_unit((const bf16*)(ws + WS_U), (bf16*)(ws + WS_Y), u, wv0);
#endif
            }
            GRID_BAR();
        } else {
            {   WS_FRESH();
                Epi<EPI_OIN> E{(GAS const float*)(ws + WS_SSP), nullptr, nullptr, nullptr, nullptr, (GAS unsigned char*)ws, lds};
#if PH & 16
                for (int rep_ = 0; rep_ < O1_REP; ++rep_)
                run_gemm<EPI_OIN>(lds, (const bf16*)(ws + WS_XB), (const bf16*)(ws + WS_OIN) + (size_t)li * 1536 * 1024, 1536, 1024, E, G, wv0);
#endif
            }
            GRID_BAR();
            {   WS_FRESH();
                Epi<EPI_UQ> E1{(GAS const float*)(ws + WS_SSQ), nullptr, nullptr, nullptr, nullptr, (GAS unsigned char*)ws, lds};
#if PH & 32
                for (int rep_ = 0; rep_ < O2_REP; ++rep_)
                run_gemm<EPI_UQ>(lds, (const bf16*)(ws + WS_CQ), (const bf16*)(ws + WS_UQ) + (size_t)li * 768 * 256, 768, 256, E1, G, wv0);
#endif
                Epi<EPI_UKV> E2{(GAS const float*)(ws + WS_SSKV), nullptr, nullptr, nullptr, nullptr, (GAS unsigned char*)ws, lds};
#if PH & 64
                for (int rep_ = 0; rep_ < O2_REP; ++rep_)
                run_gemm<EPI_UKV>(lds, (const bf16*)(ws + WS_CKV), (const bf16*)(ws + WS_UKV) + (size_t)li * 1024 * 128, 1024, 128, E2, G, wv0);
#endif
                __syncthreads();
#if PH & 128
                lru_phase<0>(P, li, lds, wv0, bx, G);
#endif
            }
            GRID_BAR();
            {   WS_FRESH();
                const bf16* QM = (const bf16*)(ws + WS_QM); const bf16* KN = (const bf16*)(ws + WS_KN); const bf16* KR = (const bf16*)(ws + WS_KR); const bf16* VM = (const bf16*)(ws + WS_VM);
#if PH & 256
                for (int rep_ = 0; rep_ < MLA_REP; ++rep_)
                for (int u = vcu; u < 2 * 8 * 64; u += G) {
                    int bh, qb;
                    if (G == 256) { const int xcd = vcu >> 5, idx = vcu & 31, i = u >> 8; bh = 2 * xcd + (i >> 1); qb = (i & 1) * 32 + idx; }
                    else { bh = u >> 6; qb = u & 63; }
                    mla_unit(QM, KN, KR, VM, (bf16*)(ws + WS_Y), bh >> 3, bh & 7, qb, lds, wv0);
                }
#endif
#if PH & 512
                lru_phase<1>(P, li, lds, wv0, bx, G);
#endif
            }
            GRID_BAR();
        }
        for (int half = 0; half < 2; ++half) {
            WS_FRESH();
            if (half == 1) {
                Epi<EPI_MLP1> E{(GAS const float*)(ws + WS_SSP), nullptr, nullptr, nullptr, nullptr, (GAS unsigned char*)ws, lds};
#if PH & 1024
                for (int rep_ = 0; rep_ < M1_REP; ++rep_)
                run_gemm<EPI_MLP1>(lds, (const bf16*)(ws + WS_XB), (const bf16*)(ws + WS_M1) + (size_t)layer * 4096 * 1024, 4096, 1024, E, G, wv0);
#endif
                GRID_BAR();
                WS_FRESH();
            }
            const bf16* A = half ? (const bf16*)(ws + WS_H) : (const bf16*)(ws + WS_Y);
            const bf16* Bt = half ? (const bf16*)(ws + WS_M2) + (size_t)layer * 4096 * 1024 : ((layer & 1) ? (const bf16*)(ws + WS_OOUT) : (const bf16*)(ws + WS_EOUT)) + (size_t)li * 1024 * 1024;
            const float* xold = (layer == 0 && half == 0) ? P.in[0] : P.out;
            Epi<EPI_RES> E{nullptr, nullptr, nullptr, (GAS bf16*)(ws + WS_XB), (GAS float*)(ws + WS_SSP), (GAS unsigned char*)ws, lds};
            (void)xold;
#if PH & 2048
            run_gemm<EPI_RES>(lds, A, Bt, 1024, half ? 4096 : 1024, E, G, wv0);
#endif
            GRID_BAR();
        }
    }
    for (int rep_ = 0; rep_ < SYNC_EXTRA; ++rep_) GRID_BAR();
    {   WS_FRESH();
        int tidf_ = wv0 * 64 + lane_id(); asm volatile("" : "+v"(tidf_));
        const long gw = ((long)bx * 512 + tidf_) >> 6, ngw = ((long)G * 512) >> 6; const int lane = tidf_ & 63;
        const float* ssp = (const float*)(ws + WS_SSP); const f32x4* gn = (const f32x4*)P.in[24] + lane;
        f32x4 g4[4];
#pragma unroll
        for (int j = 0; j < 4; ++j) g4[j] = gn[64 * j];
        for (long row = gw; row < MTOK; row += ngw) {
            const float rs = row_rstd<4>(ssp, (int)row, 1.f / 1024.f);
            f32x4* xr = (f32x4*)(P.out + (size_t)row * DM) + lane;
            const u32x2* xbr = (const u32x2*)((const bf16*)(ws + WS_XB) + (size_t)row * DM) + lane;
            u32x2 w[4];
#pragma unroll
            for (int j = 0; j < 4; ++j) w[j] = xbr[64 * j];
#pragma unroll
            for (int j = 0; j < 4; ++j) { const f32x4 v = {bflo(w[j].x), bfhi(w[j].x), bflo(w[j].y), bfhi(w[j].y)}; xr[64 * j] = v * rs * g4[j]; }
        }
    }
}

extern "C" void kernel_launch(void* const* d_in, const int* in_sizes, int n_in, void* d_out, int out_size, void* d_ws, size_t ws_size, hipStream_t stream) {
    static int grid = 0;
    if (grid == 0) {
        if (n_in != 25 || out_size != MTOK * DM || ws_size < WS_END) { fprintf(stderr, "kernel_launch: unexpected shapes (n_in %d, out %d, ws %zu)\n", n_in, out_size, ws_size); grid = -1; return; }
        int dev = 0, cus = 0, per = 0;
        (void)hipGetDevice(&dev); (void)hipDeviceGetAttribute(&cus, hipDeviceAttributeMultiprocessorCount, dev);
        (void)hipFuncSetAttribute((const void*)fwd_megakernel, hipFuncAttributeMaxDynamicSharedMemorySize, LDS_BYTES);
        (void)hipOccupancyMaxActiveBlocksPerMultiprocessor(&per, (const void*)fwd_megakernel, 512, LDS_BYTES);
        if (per < 1) per = 1;
        grid = cus * per;
        fprintf(stderr, "kernel_launch: grid %d (cus %d x %d)\n", grid, cus, per);
    }
    if (grid < 0) return;
    Params p{};
    for (int i = 0; i < 25; ++i) p.in[i] = (const float*)d_in[i];
    p.out = (float*)d_out; p.ws = (unsigned char*)d_ws;
    (void)hipMemsetAsync((char*)d_ws + WS_CTL, 0, CTL_ZERO_BYTES, stream);
    void* args[] = {&p};
    hipError_t e = hipLaunchCooperativeKernel((void*)fwd_megakernel, dim3(grid), dim3(512), args, LDS_BYTES, stream);
    if (e != hipSuccess) fprintf(stderr, "kernel_launch: cooperative launch failed: %s (grid %d)\n", hipGetErrorString(e), grid);
}
```

```cpp
#include <hip/hip_runtime.h>
#include <hip/hip_cooperative_groups.h>
#include <cstdio>
#include <cstdint>
#include <cmath>
namespace cg = cooperative_groups;
namespace pg8 {
#define PG8_LAS __attribute__((address_space(3)))
typedef unsigned short bf16_t;
typedef short bf16x8 __attribute__((ext_vector_type(8)));
typedef float f32x4 __attribute__((ext_vector_type(4)));
typedef unsigned u32x4 __attribute__((ext_vector_type(4)));
constexpr int BM = 256, BK = 64, HALF = 128, HTB = HALF * BK * 2  , STAGE_BYTES = 8 * HTB, NXCD = 8, WGM = 8;

__host__ __device__ __forceinline__ int lds_byte(int r, int c) { const int st = (r >> 4) * 2 + (c >> 5), rr = r & 15, cc = c & 31, ob = rr * 64 + cc * 2; return st * 1024 + (ob ^ (((ob >> 9) & 1) << 5)); }
__host__ __device__ __forceinline__ void stage_rc(int b, int& R, int& C) { const int st = b / 1024, sb = b % 1024, swz = sb ^ (((sb >> 9) & 1) << 5); R = (st >> 1) * 16 + swz / 64; C = (st & 1) * 32 + (swz % 64) / 2; }
__host__ __device__ __forceinline__ int perm32(int rho) { const int n = rho >> 4, i = rho & 15; return 8 * (i >> 2) + 4 * n + (i & 3); }

struct Unit { int pm, pn; };
struct Gemm { const bf16_t* A; const bf16_t* Bt; int M, N, K; int wv; };

struct StaticOrder {
    int nM, nN, nwg, G, c;
    __host__ __device__ void init(int M, int N, int G_, int c_) { nM = M / BM; nN = N / BM; nwg = nM * nN; G = G_; c = c_; }
    __host__ __device__ bool next(int i, Unit& u) const {
        const long L = (long)i * G + c; if (L >= nwg) return false;
        int wgid = (int)L; { const int q = nwg / NXCD, r = nwg % NXCD, xcd = wgid % NXCD, off = wgid / NXCD; wgid = (xcd < r ? xcd * (q + 1) : r * (q + 1) + (xcd - r) * q) + off; }
        const int nig = WGM * nN, gid = wgid / nig, fm = gid * WGM, gsz = (nM - fm) < WGM ? (nM - fm) : WGM;
        u.pm = fm + ((wgid % nig) % gsz); u.pn = (wgid % nig) / gsz; return true;
    }
    __device__ __forceinline__ void a_ready(const Unit&) const {}
    __device__ __forceinline__ void done(const Unit&) const {}
};

__device__ __forceinline__ unsigned cvt_pk_bf16(float lo, float hi) { unsigned r; asm volatile("v_cvt_pk_bf16_f32 %0, %1, %2" : "=v"(r) : "v"(lo), "v"(hi)); return r; }
typedef float f32x2 __attribute__((ext_vector_type(2)));
template <class Epi, class Sched, bool ALIGN_EPI = false, bool SP2 = false>
__device__ __forceinline__ void gemm_phase(PG8_LAS unsigned char* lds, const Gemm g, const Sched& S, const Epi& E) {
    int lid_; asm volatile("v_mbcnt_lo_u32_b32 %0, -1, 0\n\tv_mbcnt_hi_u32_b32 %0, -1, %0" : "=v"(lid_)); int tid_ = g.wv * 64 + lid_;
    const int tid = tid_, wid = __builtin_amdgcn_readfirstlane(tid >> 6), lane = tid & 63, wr = wid >> 2, wc = wid & 3, fr = lane & 15, fq = lane >> 4;
    int K_ = g.K; asm volatile("" : "+s"(K_)); const int K = K_, nt = K / BK;
    unsigned voffA[2], voffB[2];
#pragma unroll
    for (int i = 0; i < 2; ++i) { int R, C; stage_rc(tid * 16 + i * 8192, R, C); const int Rb = Epi::PERM ? ((R & ~31) + perm32(R & 31)) : R;
        voffA[i] = (unsigned)(R * K + C) * 2u; voffB[i] = (unsigned)(Rb * K + C) * 2u; }
    const size_t kstep = (size_t)(BK * 2);
    const size_t hstep = (size_t)HALF * K * 2;
    const size_t tstep = 2 * hstep;
    const unsigned ldsw = (unsigned)wid * 1024u;
    const int aoff = lds_byte(wr * 64 + fr, fq * 8), boff = lds_byte(wc * 32 + fr, fq * 8);
#define PG8_SA(b, h) (((b) * 2 + (h)) * HTB)
#define PG8_SB(b, h) ((4 + (b) * 2 + (h)) * HTB)
#define PG8_STAGE(bufoff, gbase, voff) do { _Pragma("unroll") for (int _i = 0; _i < 2; ++_i) \
        __builtin_amdgcn_global_load_lds((const unsigned*)((const char*)(gbase) + (voff)[_i]), (PG8_LAS unsigned*)(lds + (bufoff) + ldsw + _i * 8192), 16, 0, 0); } while (0)
#define PG8_LDA(dst, b, h) do { _Pragma("unroll") for (int m = 0; m < 4; ++m) _Pragma("unroll") for (int k = 0; k < 2; ++k) dst[m][k] = *(const PG8_LAS bf16x8*)(lds + PG8_SA(b, h) + aoff + m * 2048 + k * 1024); } while (0)
#define PG8_LDB(dst, b, h) do { _Pragma("unroll") for (int n = 0; n < 2; ++n) _Pragma("unroll") for (int k = 0; k < 2; ++k) dst[n][k] = *(const PG8_LAS bf16x8*)(lds + PG8_SB(b, h) + boff + n * 2048 + k * 1024); } while (0)
#define PG8_MMA(ai, bj, At, Bt) do { __builtin_amdgcn_s_setprio(1); _Pragma("unroll") for (int m = 0; m < 4; ++m) _Pragma("unroll") for (int n = 0; n < 2; ++n) _Pragma("unroll") for (int k = 0; k < 2; ++k) \
        acc[ai][bj][m][n] = __builtin_amdgcn_mfma_f32_16x16x32_bf16(Bt[n][k], At[m][k], acc[ai][bj][m][n], 0, 0, 0); __builtin_amdgcn_s_setprio(0); } while (0)
#define PG8_WAIT_V(n) asm volatile("s_waitcnt vmcnt(" #n ")" ::: "memory")
#define PG8_WAIT_L(n) asm volatile("s_waitcnt lgkmcnt(" #n ")" ::: "memory")
#define PG8_BAR __builtin_amdgcn_s_barrier()
#define PG8_SCHED __builtin_amdgcn_sched_barrier(0)
    Unit cur, nxt; int ui = 0;
    if (!S.next(0, cur)) return;
    f32x4 acc[2][2][4][2];
#pragma unroll
    for (int a = 0; a < 2; ++a)
#pragma unroll
        for (int b = 0; b < 2; ++b)
#pragma unroll
            for (int m = 0; m < 4; ++m)
#pragma unroll
                for (int n = 0; n < 2; ++n) acc[a][b][m][n] = (f32x4){0.f, 0.f, 0.f, 0.f};
    bf16x8 At[4][2], B0[2][2], B1[2][2];
    const char* cA = (const char*)g.A + (size_t)cur.pm * tstep; const char* cB = (const char*)g.Bt + (size_t)cur.pn * tstep;
    S.a_ready(cur);
    if constexpr (SP2) {
        PG8_STAGE(PG8_SB(0, 0), cB, voffB); PG8_STAGE(PG8_SB(0, 1), cB + hstep, voffB); PG8_STAGE(PG8_SA(0, 0), cA, voffA); PG8_STAGE(PG8_SA(0, 1), cA + hstep, voffA);
        if (wr == 1) PG8_BAR;
        PG8_WAIT_V(2); PG8_BAR;
        PG8_STAGE(PG8_SB(1, 0), cB + kstep, voffB); PG8_STAGE(PG8_SA(1, 0), cA + kstep, voffA); PG8_STAGE(PG8_SB(1, 1), cB + hstep + kstep, voffB);
        PG8_WAIT_V(6); PG8_BAR;
    } else {
        PG8_STAGE(PG8_SB(0, 0), cB, voffB); PG8_STAGE(PG8_SA(0, 0), cA, voffA); PG8_STAGE(PG8_SB(0, 1), cB + hstep, voffB); PG8_STAGE(PG8_SA(0, 1), cA + hstep, voffA);
        if (wr == 1) PG8_BAR;
        PG8_WAIT_V(4); PG8_BAR;
        PG8_STAGE(PG8_SB(1, 0), cB + kstep, voffB); PG8_STAGE(PG8_SA(1, 0), cA + kstep, voffA); PG8_STAGE(PG8_SB(1, 1), cB + hstep + kstep, voffB);
        PG8_WAIT_V(6); PG8_BAR;
    }
    for (;;) {
        const bool has_next = S.next(ui + 1, nxt);
        const char* nA = has_next ? (const char*)g.A + (size_t)nxt.pm * tstep : cA; const char* nB = has_next ? (const char*)g.Bt + (size_t)nxt.pn * tstep : cB;
        asm volatile(".p2align 6" ::: "memory");
        for (int t = 0; t < nt; t += 2) {
            const bool last = (t == nt - 2);
            const char* a1 = cA + (size_t)(t + 1) * kstep;
            const char* a2 = last ? nA : cA + (size_t)(t + 2) * kstep; const char* b2 = last ? nB : cB + (size_t)(t + 2) * kstep;
            const char* a3 = a2 + kstep; const char* b3 = b2 + kstep;
            if (last && has_next) S.a_ready(nxt);
            if constexpr (SP2) {
            PG8_LDB(B0, 0, 0); PG8_LDB(B1, 0, 1); PG8_SCHED; PG8_LDA(At, 0, 0); PG8_STAGE(PG8_SA(1, 1), a1 + hstep, voffA);
            PG8_WAIT_V(8); PG8_WAIT_L(0); PG8_BAR; PG8_MMA(0, 0, At, B0); PG8_MMA(0, 1, At, B1); PG8_BAR; PG8_SCHED;
            PG8_LDA(At, 0, 1); PG8_STAGE(PG8_SB(0, 0), b2, voffB); PG8_STAGE(PG8_SB(0, 1), b2 + hstep, voffB); PG8_STAGE(PG8_SA(0, 0), a2, voffA);
            PG8_WAIT_V(8); PG8_WAIT_L(0); PG8_BAR; PG8_MMA(1, 0, At, B0); PG8_MMA(1, 1, At, B1); PG8_BAR; PG8_SCHED;
            PG8_LDB(B0, 1, 0); PG8_LDB(B1, 1, 1); PG8_SCHED; PG8_LDA(At, 1, 0); PG8_STAGE(PG8_SA(0, 1), a2 + hstep, voffA);
            PG8_WAIT_V(8); PG8_WAIT_L(0); PG8_BAR; PG8_MMA(0, 0, At, B0); PG8_MMA(0, 1, At, B1); PG8_BAR; PG8_SCHED;
            PG8_LDA(At, 1, 1); PG8_STAGE(PG8_SB(1, 0), b3, voffB); PG8_STAGE(PG8_SB(1, 1), b3 + hstep, voffB); PG8_STAGE(PG8_SA(1, 0), a3, voffA);
            PG8_WAIT_V(8); PG8_WAIT_L(0); PG8_BAR; PG8_MMA(1, 0, At, B0); PG8_MMA(1, 1, At, B1); PG8_BAR; PG8_SCHED;
            } else {
            PG8_LDB(B0, 0, 0); PG8_SCHED; PG8_LDA(At, 0, 0); PG8_STAGE(PG8_SA(1, 1), a1 + hstep, voffA);
            PG8_WAIT_L(8); PG8_BAR; PG8_WAIT_L(0); PG8_MMA(0, 0, At, B0); PG8_BAR; PG8_SCHED;
            PG8_LDB(B1, 0, 1); PG8_STAGE(PG8_SB(0, 0), b2, voffB);
            PG8_BAR; PG8_WAIT_L(0); PG8_MMA(0, 1, At, B1); PG8_BAR;
            PG8_LDA(At, 0, 1); PG8_STAGE(PG8_SA(0, 0), a2, voffA);
            PG8_BAR; PG8_WAIT_L(0); PG8_MMA(1, 0, At, B0); PG8_BAR; PG8_SCHED;
            PG8_STAGE(PG8_SB(0, 1), b2 + hstep, voffB);
            PG8_WAIT_V(6); PG8_BAR; PG8_MMA(1, 1, At, B1); PG8_BAR;
            PG8_LDB(B0, 1, 0); PG8_SCHED; PG8_LDA(At, 1, 0); PG8_STAGE(PG8_SA(0, 1), a2 + hstep, voffA);
            PG8_WAIT_L(8); PG8_BAR; PG8_WAIT_L(0); PG8_MMA(0, 0, At, B0); PG8_BAR; PG8_SCHED;
            PG8_LDB(B1, 1, 1); PG8_STAGE(PG8_SB(1, 0), b3, voffB);
            PG8_BAR; PG8_WAIT_L(0); PG8_MMA(0, 1, At, B1); PG8_BAR;
            PG8_LDA(At, 1, 1); PG8_STAGE(PG8_SA(1, 0), a3, voffA);
            PG8_BAR; PG8_WAIT_L(0); PG8_MMA(1, 0, At, B0); PG8_BAR; PG8_SCHED;
            PG8_STAGE(PG8_SB(1, 1), b3 + hstep, voffB);
            PG8_WAIT_V(6); PG8_BAR; PG8_MMA(1, 1, At, B1); PG8_BAR;
            }
        }
        if constexpr (ALIGN_EPI) { if (wr == 0) PG8_BAR; }
        if constexpr (!Epi::AFTER_DRAIN) { E(acc, cur, wr, wc, fr, fq); S.done(cur); }
        if (!has_next) break;
#pragma unroll
        for (int a = 0; a < 2; ++a)
#pragma unroll
            for (int b = 0; b < 2; ++b)
#pragma unroll
                for (int m = 0; m < 4; ++m)
#pragma unroll
                    for (int n = 0; n < 2; ++n) acc[a][b][m][n] = (f32x4){0.f, 0.f, 0.f, 0.f};
        cur = nxt; cA = nA; cB = nB; ++ui;
        if constexpr (ALIGN_EPI) { if (wr == 1) PG8_BAR; }
    }
    PG8_WAIT_V(0);
    if constexpr (!ALIGN_EPI) { if (wr == 0) PG8_BAR; }
    PG8_BAR;
    if constexpr (Epi::AFTER_DRAIN) { E.fused(acc, cur, wr, wc, fr, fq, lds, wid, lane); S.done(cur); }
#undef PG8_SA
#undef PG8_SB
#undef PG8_STAGE
#undef PG8_LDA
#undef PG8_LDB
#undef PG8_MMA
#undef PG8_WAIT_V
#undef PG8_WAIT_L
#undef PG8_BAR
#undef PG8_SCHED
}
}
#ifndef MLA_REP
#define MLA_REP 1
#endif
#ifndef PRO_REP
#define PRO_REP 1
#endif
#ifndef WIN_REP
#define WIN_REP 1
#endif
#ifndef LRU_REP
#define LRU_REP 1
#endif
#ifndef M1_REP
#define M1_REP 1
#endif
#ifndef E1_REP
#define E1_REP 1
#endif
#ifndef O1_REP
#define O1_REP 1
#endif
#ifndef O2_REP
#define O2_REP 1
#endif
#ifndef SYNC_EXTRA
#define SYNC_EXTRA 0
#endif
#ifndef MLA_SGB
#define MLA_SGB 1
#endif
#ifndef PH
#define PH 0xFFFF
#endif

constexpr int BATCH = 2, SEQ = 16384, DM = 1024, MTOK = BATCH * SEQ, DFF = 4096, DEPTH = 4;
constexpr float EPS = 1e-6f, LOG2E = 1.4426950408889634f;
constexpr float QSCALE_A = 0.125f * LOG2E;
constexpr float QSCALE_C = 0.10206207261596577f * LOG2E;

#define LAS __attribute__((address_space(3)))
#define DI __device__ __forceinline__
typedef unsigned short bf16;
typedef short bf16x8 __attribute__((ext_vector_type(8)));
typedef short s16x4 __attribute__((ext_vector_type(4)));
typedef float f32x4 __attribute__((ext_vector_type(4)));
typedef float f32x2 __attribute__((ext_vector_type(2)));
typedef float f32x16 __attribute__((ext_vector_type(16)));
typedef unsigned u32x4 __attribute__((ext_vector_type(4)));
typedef unsigned u32x2 __attribute__((ext_vector_type(2)));
#define MFMA32(a, b, c) __builtin_amdgcn_mfma_f32_32x32x16_bf16((a), (b), (c), 0, 0, 0)

constexpr size_t MiB = (size_t)1 << 20;
constexpr size_t WS_CTL = 0, CTL_ZERO_BYTES = 16384, WS_SP = 65536;
constexpr size_t WS_EIN = 1 * MiB, WS_EOUT = 6 * MiB, WS_OIN = 10 * MiB, WS_UQ = 16 * MiB, WS_UKV = 17 * MiB, WS_OOUT = 18 * MiB;
constexpr size_t WS_M1 = 22 * MiB, WS_M2 = 54 * MiB, WS_WG = 86 * MiB, WS_ROPA = 87 * MiB, WS_ROPC = 91 * MiB;
constexpr size_t WS_SSP = 93 * MiB, WS_SSQ = 95 * MiB, WS_SSKV = 96 * MiB, WS_SUM = 97 * MiB, WS_CSUM = 105 * MiB;
constexpr size_t WS_XB = 112 * MiB, WS_Y = 176 * MiB, WS_H = 240 * MiB;
constexpr size_t WS_Q = 240 * MiB, WS_K = 272 * MiB, WS_V = 280 * MiB, WS_U = 288 * MiB;
constexpr size_t WS_CQ = 240 * MiB, WS_CKV = 256 * MiB, WS_KR = 264 * MiB, WS_XR = 272 * MiB, WS_GXG = 304 * MiB;
constexpr size_t WS_QM = 336 * MiB, WS_KN = 384 * MiB, WS_VM = 420 * MiB;
constexpr int KROW = 544;
constexpr size_t WS_END = 496 * MiB;
constexpr int LDS_BYTES = 147456;

struct Params { const float* in[25]; float* out; unsigned char* ws; };

DI unsigned cvtpk(float lo, float hi) { typedef __bf16 b2 __attribute__((ext_vector_type(2))); f32x2 v = {lo, hi}; b2 b = __builtin_convertvector(v, b2); return __builtin_bit_cast(unsigned, b); }
DI float bflo(unsigned w) { return __uint_as_float(w << 16); }
DI float bfhi(unsigned w) { return __uint_as_float(w & 0xffff0000u); }
DI u32x4 pack8(const float (&v)[8]) { u32x4 o; o.x = cvtpk(v[0], v[1]); o.y = cvtpk(v[2], v[3]); o.z = cvtpk(v[4], v[5]); o.w = cvtpk(v[6], v[7]); return o; }
DI void unpack8(const u32x4 w, float (&v)[8]) { v[0] = bflo(w.x); v[1] = bfhi(w.x); v[2] = bflo(w.y); v[3] = bfhi(w.y); v[4] = bflo(w.z); v[5] = bfhi(w.z); v[6] = bflo(w.w); v[7] = bfhi(w.w); }
DI float sigm(float x) { return 1.f / (1.f + __expf(-x)); }
DI float gelu_tanh(float x) { const float u = 0.7978845608028654f * (x + 0.044715f * x * x * x); const float e = __expf(2.f * u); const float t = 1.f - 2.f / (e + 1.f); return 0.5f * x * (1.f + t); }
DI int lane_id() { int l; asm volatile("v_mbcnt_lo_u32_b32 %0, -1, 0\n\tv_mbcnt_hi_u32_b32 %0, -1, %0" : "=v"(l)); return l; }
DI int crow(int i, int h) { return (i & 3) + 8 * (i >> 2) + 4 * h; }
DI float swap_max(float v) { auto rr = __builtin_amdgcn_permlane32_swap(__float_as_uint(v), __float_as_uint(v), false, false); return fmaxf(__uint_as_float(rr[0]), __uint_as_float(rr[1])); }
DI float swap_sum(float v) { auto rr = __builtin_amdgcn_permlane32_swap(__float_as_uint(v), __float_as_uint(v), false, false); return __uint_as_float(rr[0]) + __uint_as_float(rr[1]); }
DI s16x4 vtr(const LAS unsigned char* p) { typedef short v4i16_t __attribute__((ext_vector_type(4))); return __builtin_bit_cast(s16x4, __builtin_amdgcn_ds_read_tr16_b64_v4i16((LAS v4i16_t*)p)); }
DI void sincos_acc(float angf, float& s, float& c) {
    const double a = (double)angf;
    const double q = rint(a * 0.6366197723675814);
    double r = a - q * 1.5707963267948966; r = r - q * 6.123233995736766e-17;
    const double r2 = r * r;
    const double sp = r * (1.0 + r2 * (-1.0 / 6 + r2 * (1.0 / 120 + r2 * (-1.0 / 5040 + r2 * (1.0 / 362880 + r2 * (-1.0 / 39916800 + r2 * (1.0 / 6227020800.0 + r2 * (-1.0 / 1307674368000.0))))))));
    const double cp = 1.0 + r2 * (-0.5 + r2 * (1.0 / 24 + r2 * (-1.0 / 720 + r2 * (1.0 / 40320 + r2 * (-1.0 / 3628800 + r2 * (1.0 / 479001600.0 + r2 * (-1.0 / 87178291200.0 + r2 * (1.0 / 20922789888000.0))))))));
    const int qi = (int)((long long)q & 3);
    const double ss = (qi == 0) ? sp : (qi == 1) ? cp : (qi == 2) ? -sp : -cp;
    const double cc = (qi == 0) ? cp : (qi == 1) ? -sp : (qi == 2) ? -cp : sp;
    s = (float)ss; c = (float)cc;
}

template <class F>
DI void conv_wt(const float* __restrict__ W, int K, int Nsrc, bf16* __restrict__ Bt, int Ndst, int ldb, int kdst_off, const float* __restrict__ gain, F colmap, LAS float* scr, int lane, int gw, int ngw) {
    const int nkt = K / 64, nnt = Ndst / 64, items = nkt * nnt;
    for (int it = gw; it < items; it += ngw) {
        const int nb = it % nnt, kb = it / nnt, n0 = nb * 64, k0 = kb * 64;
        const int src = colmap(n0 + lane);
        const float* wp = W + (size_t)k0 * Nsrc + (src < 0 ? 0 : src);
        float wv[64];
#pragma unroll
        for (int kk = 0; kk < 64; ++kk) wv[kk] = wp[(size_t)kk * Nsrc];
#pragma unroll
        for (int kk = 0; kk < 64; ++kk) { float w = wv[kk]; if (gain) w *= gain[k0 + kk]; scr[kk * 65 + lane] = (src < 0) ? 0.f : w; }
        asm volatile("s_waitcnt lgkmcnt(0)" ::: "memory");
        const int c = lane & 7;
#pragma unroll
        for (int j = 0; j < 8; ++j) { const int n = (lane >> 3) + 8 * j; const LAS float* sp = scr + (8 * c) * 65 + n;
            float v[8];
#pragma unroll
            for (int q = 0; q < 8; ++q) v[q] = sp[q * 65];
            *(u32x4*)(Bt + (size_t)(n0 + n) * ldb + kdst_off + k0 + 8 * c) = pack8(v); }
        asm volatile("s_waitcnt lgkmcnt(0)" ::: "memory");
    }
}
struct MapId { DI int operator()(int n) const { return n; } };
struct MapEin { DI int operator()(int n) const { if (n >= 640) return n; const int base = n & ~63, i = n & 63; return base + (i >> 1) + 32 * (i & 1); } };
struct MapOin { DI int operator()(int n) const {
    if (n < 384) return n;
    if (n < 416) { const int i = n - 384; return 384 + (i >> 1) + 16 * (i & 1); }
    if (n < 512) return -1;
    if (n < 1024) return 416 + (n - 512);
    return 928 + (n - 1024); } };
struct MapUq { DI int operator()(int n) const { const int h = n / 96, w = n - 96 * h; if (w < 64) return n; const int i = w - 64; return h * 96 + 64 + (i >> 1) + 16 * (i & 1); } };
struct MapUkv { DI int operator()(int n) const { if (n < 512) { const int h = n >> 6, d = n & 63; return h * 128 + d; } const int m = n - 512, h = m >> 6, d = m & 63; return h * 128 + 64 + d; } };

DI void prologue(const Params& P, long gtid, long gthreads, LAS unsigned char* lds) {
    unsigned char* ws = P.ws;
    const int lane = (int)(gtid & 63), gwv = (int)(gtid >> 6), ngwv = (int)(gthreads >> 6);
    LAS float* scr = (LAS float*)lds + ((int)(gtid >> 6) & 7) * (64 * 65);
    for (int e = 0; e < 2; ++e) {
        conv_wt(P.in[2] + (size_t)e * 1024 * 1280, 1024, 1280, (bf16*)(ws + WS_EIN) + (size_t)e * 1280 * 1024, 1280, 1024, 0, P.in[1] + e * 1024, MapEin(), scr, lane, gwv, ngwv);
        conv_wt(P.in[6] + (size_t)e * 1024 * 1024, 512, 1024, (bf16*)(ws + WS_EOUT) + (size_t)e * 1024 * 1024, 1024, 1024, 0, nullptr, MapId(), scr, lane, gwv, ngwv);
        const float* wp = P.in[4] + (size_t)e * 4 * 128 * 128; const float* sc = P.in[5] + e * 512; const float* wo = P.in[6] + (size_t)e * 1024 * 1024; bf16* bt = (bf16*)(ws + WS_EOUT) + (size_t)e * 1024 * 1024;
        for (long it = gtid; it < 1024 * 64; it += gthreads) {
            const int n = (int)(it & 1023), kk0 = (int)(it >> 10) * 8, g = kk0 >> 7;
            float acc[8];
#pragma unroll
            for (int q = 0; q < 8; ++q) acc[q] = 0.f;
            for (int j = 0; j < 128; ++j) {
                const float wv = wo[(size_t)(512 + g * 128 + j) * 1024 + n] * sc[g * 128 + j];
#pragma unroll
                for (int q = 0; q < 8; ++q) acc[q] += wp[(size_t)(g * 128 + ((kk0 + q) & 127)) * 128 + j] * wv;
            }
            *(u32x4*)(bt + (size_t)n * 1024 + 512 + kk0) = pack8(acc);
        }
    }
    for (int o = 0; o < 2; ++o) {
        conv_wt(P.in[8] + (size_t)o * 1024 * 1440, 1024, 1440, (bf16*)(ws + WS_OIN) + (size_t)o * 1536 * 1024, 1536, 1024, 0, P.in[7] + o * 1024, MapOin(), scr, lane, gwv, ngwv);
        conv_wt(P.in[10] + (size_t)o * 256 * 768, 256, 768, (bf16*)(ws + WS_UQ) + (size_t)o * 768 * 256, 768, 256, 0, P.in[9] + o * 256, MapUq(), scr, lane, gwv, ngwv);
        conv_wt(P.in[12] + (size_t)o * 128 * 1024, 128, 1024, (bf16*)(ws + WS_UKV) + (size_t)o * 1024 * 128, 1024, 128, 0, P.in[11] + o * 128, MapUkv(), scr, lane, gwv, ngwv);
        conv_wt(P.in[20] + (size_t)o * 1024 * 1024, 1024, 1024, (bf16*)(ws + WS_OOUT) + (size_t)o * 1024 * 1024, 1024, 1024, 0, nullptr, MapId(), scr, lane, gwv, ngwv);
    }
    for (int l = 0; l < DEPTH; ++l) {
        conv_wt(P.in[22] + (size_t)l * 1024 * 4096, 1024, 4096, (bf16*)(ws + WS_M1) + (size_t)l * 4096 * 1024, 4096, 1024, 0, P.in[21] + l * 1024, MapId(), scr, lane, gwv, ngwv);
        conv_wt(P.in[23] + (size_t)l * 4096 * 1024, 4096, 1024, (bf16*)(ws + WS_M2) + (size_t)l * 4096 * 1024, 1024, 4096, 0, nullptr, MapId(), scr, lane, gwv, ngwv);
    }
    for (long it = gtid; it < 2 * 8 * 4 * 64 * 8; it += gthreads) {
        const int j = (int)(it & 63), ic = (int)(it >> 6) & 7, g = (int)(it >> 9) & 3, n = (int)(it >> 11) & 7, o = (int)(it >> 14);
        const float* src = ((g & 1) ? P.in[17] : P.in[15]) + (size_t)(((o * 2 + (g >> 1)) * 8 + n)) * 4096;
        float v[8];
#pragma unroll
        for (int q = 0; q < 8; ++q) v[q] = src[(ic * 8 + q) * 64 + j];
        *(u32x4*)((bf16*)(ws + WS_WG) + (size_t)(((o * 8 + n) * 4 + g)) * 4096 + j * 64 + ic * 8) = pack8(v);
    }
    for (long it = gtid; it < 2 * 2 * 512; it += gthreads) ((float*)(ws + WS_SP))[it] = log1pf(expf(-P.in[19][it]));
    float* ca = (float*)(ws + WS_ROPA); float* sa = ca + SEQ * 32; float* cc = (float*)(ws + WS_ROPC); float* sc2 = cc + SEQ * 16;
    for (long it = gtid; it < (long)SEQ * 32; it += gthreads) {
        const int pos = (int)(it >> 5), p = (int)(it & 31);
        const float inv = powf(10000.f, -(float)p / 32.f); float s, c; sincos_acc((float)pos * inv, s, c); ca[it] = c; sa[it] = s;
    }
    for (long it = gtid; it < (long)SEQ * 16; it += gthreads) {
        const int pos = (int)(it >> 4), p = (int)(it & 15);
        const float inv = powf(10000.f, -(float)p / 16.f); float s, c; sincos_acc((float)pos * inv, s, c); cc[it] = c; sc2[it] = s;
    }
    const long gw = gtid >> 6, ngw = gthreads >> 6;
    bf16* xb = (bf16*)(ws + WS_XB); float* ssp = (float*)(ws + WS_SSP);
    for (long row = gw; row < MTOK; row += ngw) {
        const f32x4* xr = (const f32x4*)(P.in[0] + (size_t)row * DM) + lane; float s = 0.f;
#pragma unroll
        for (int j = 0; j < 4; ++j) { const f32x4 v = xr[64 * j]; s += (v.x * v.x + v.y * v.y) + (v.z * v.z + v.w * v.w);
            u32x2 w; w.x = cvtpk(v.x, v.y); w.y = cvtpk(v.z, v.w); *((u32x2*)(xb + (size_t)row * DM) + lane + 64 * j) = w; }
#pragma unroll
        for (int o = 1; o < 64; o <<= 1) s += __shfl_xor(s, o);
        if (lane < 4) ssp[row * 4 + lane] = (lane == 0) ? s : 0.f;
    }
}

#define GAS __attribute__((address_space(1)))
template <int NP> DI float row_rstd(const float* part, int row, float inv_n) {
    float s;
    if (NP == 16) { const f32x4* p = (const f32x4*)(part + (size_t)row * 16); const f32x4 a = p[0], b = p[1], c = p[2], d = p[3]; s = ((a.x + a.y) + (a.z + a.w)) + ((b.x + b.y) + (b.z + b.w)) + ((c.x + c.y) + (c.z + c.w)) + ((d.x + d.y) + (d.z + d.w)); }
    else { const f32x4 a = *(const f32x4*)(part + (size_t)row * 4); s = (a.x + a.y) + (a.z + a.w); }
    return rsqrtf(s * inv_n + EPS);
}
DI float row_rstd4g(GAS const float* part, int row, float inv_n) { const f32x4 a = *(GAS const f32x4*)(part + (size_t)row * 4); return rsqrtf(((a.x + a.y) + (a.z + a.w)) * inv_n + EPS); }
enum { EPI_EIN = 0, EPI_RES = 1, EPI_MLP1 = 2, EPI_OIN = 3, EPI_UQ = 4, EPI_UKV = 5 };
template <int MODE> struct Epi {
    static constexpr bool PERM = true, AFTER_DRAIN = false;
    GAS const float* ssin;
    GAS const float* xold; GAS float* xnew; GAS bf16* xb; GAS float* ssout;
    GAS unsigned char* ws;
    LAS unsigned char* ldsbase;
    DI void rope4(float (&v)[8], GAS const float* ct, GAS const float* st, int pos, int half, int p0) const {
        const f32x4 cs = *(GAS const f32x4*)(ct + (size_t)pos * half + p0), sn = *(GAS const f32x4*)(st + (size_t)pos * half + p0);
#pragma unroll
        for (int j = 0; j < 4; ++j) { const float x1 = v[2 * j], x2 = v[2 * j + 1]; v[2 * j] = x1 * cs[j] - x2 * sn[j]; v[2 * j + 1] = x2 * cs[j] + x1 * sn[j]; }
    }
    DI void operator()(const pg8::f32x4 (&acc)[2][2][4][2], const pg8::Unit& u, int wr, int wc, int fr, int fq) const {
        const int row0 = u.pm * 256 + wr * 64 + fr, colb = u.pn * 256 + wc * 32 + 8 * fq;
        LAS float* ssl = (LAS float*)(ldsbase + 131072);
        float rsv[2][4];
#pragma unroll
        for (int ai = 0; ai < 2; ++ai)
#pragma unroll
            for (int m = 0; m < 4; ++m) {
                const int row = row0 + ai * 128 + m * 16; float rs = 1.f;
                if (MODE == EPI_EIN || MODE == EPI_MLP1 || MODE == EPI_OIN) rs = row_rstd4g(ssin, row, 1.f / 1024.f);
                if (MODE == EPI_UQ) rs = row_rstd4g(ssin, row, 1.f / 256.f);
                if (MODE == EPI_UKV) rs = row_rstd4g(ssin, row, 1.f / 128.f);
                rsv[ai][m] = rs; }
        u32x4 resid[2][4][2];
        if (MODE == EPI_RES) {
#pragma unroll
            for (int ai = 0; ai < 2; ++ai)
#pragma unroll
                for (int m = 0; m < 4; ++m)
#pragma unroll
                    for (int bj = 0; bj < 2; ++bj) resid[ai][m][bj] = *(GAS const u32x4*)(xb + (size_t)(row0 + ai * 128 + m * 16) * DM + colb + bj * 128);
        }
#pragma unroll
        for (int ai = 0; ai < 2; ++ai)
#pragma unroll
            for (int m = 0; m < 4; ++m) {
                const int row = row0 + ai * 128 + m * 16; const int pos = row & (SEQ - 1);
                const float rs = rsv[ai][m];
                float sq = 0.f;
#pragma unroll
                for (int bj = 0; bj < 2; ++bj) {
                    const int c = colb + bj * 128;
                    float v[8];
#pragma unroll
                    for (int j = 0; j < 4; ++j) { v[j] = acc[ai][bj][m][0][j] * rs; v[4 + j] = acc[ai][bj][m][1][j] * rs; }
                    if (MODE == EPI_EIN) {
                        GAS bf16* dst;
                        if (c < 640) {
                            rope4(v, (GAS const float*)(ws + WS_ROPA), (GAS const float*)(ws + WS_ROPA) + SEQ * 32, pos, 32, (c & 63) >> 1);
                            if (c < 512) {
#pragma unroll
                                for (int j = 0; j < 8; ++j) v[j] *= QSCALE_A;
                                dst = (GAS bf16*)(ws + WS_Q) + (size_t)row * 512 + c;
                            } else dst = (GAS bf16*)(ws + WS_K) + (size_t)row * 128 + (c - 512);
                        } else if (c < 768) dst = (GAS bf16*)(ws + WS_V) + (size_t)row * 128 + (c - 640);
                        else dst = (GAS bf16*)(ws + WS_U) + (size_t)row * 512 + (c - 768);
                        *(GAS u32x4*)dst = pack8(v);
                    } else if (MODE == EPI_RES) {
                        const size_t off = (size_t)row * DM + c;
                        float xo[8]; unpack8(resid[ai][m][bj], xo);
#pragma unroll
                        for (int j = 0; j < 8; ++j) v[j] += xo[j];
                        const u32x4 pk = pack8(v);
                        *(GAS u32x4*)(xb + off) = pk;
                        unpack8(pk, xo);
#pragma unroll
                        for (int j = 0; j < 8; ++j) sq += xo[j] * xo[j];
                    } else if (MODE == EPI_MLP1) {
#pragma unroll
                        for (int j = 0; j < 8; ++j) { const float t = fmaxf(v[j], 0.f); v[j] = t * t; }
                        __builtin_nontemporal_store(pack8(v), (GAS u32x4*)((GAS bf16*)(ws + WS_H) + (size_t)row * DFF + c));
                    } else if (MODE == EPI_OIN) {
                        if (c < 256) {
                            *(GAS u32x4*)((GAS bf16*)(ws + WS_CQ) + (size_t)row * 256 + c) = pack8(v);
#pragma unroll
                            for (int j = 0; j < 8; ++j) sq += v[j] * v[j];
                        } else if (c < 384) {
                            *(GAS u32x4*)((GAS bf16*)(ws + WS_CKV) + (size_t)row * 128 + (c - 256)) = pack8(v);
#pragma unroll
                            for (int j = 0; j < 8; ++j) sq += v[j] * v[j];
                        } else if (c < 416) {
                            rope4(v, (GAS const float*)(ws + WS_ROPC), (GAS const float*)(ws + WS_ROPC) + SEQ * 16, pos, 16, (c - 384) >> 1);
                            *(GAS u32x4*)((GAS bf16*)(ws + WS_KN) + (size_t)row * KROW + 512 + (c - 384)) = pack8(v);
                        } else if (c < 512) {
                        } else if (c < 1024) {
                            *(GAS u32x4*)((GAS bf16*)(ws + WS_XR) + (size_t)row * 512 + (c - 512)) = pack8(v);
                        } else {
#pragma unroll
                            for (int j = 0; j < 8; ++j) v[j] = gelu_tanh(v[j]);
                            *(GAS u32x4*)((GAS bf16*)(ws + WS_GXG) + (size_t)row * 512 + (c - 1024)) = pack8(v);
                        }
                    } else if (MODE == EPI_UQ) {
                        const int hq = c / 96, w = c - 96 * hq;
                        if (w >= 64) rope4(v, (GAS const float*)(ws + WS_ROPC), (GAS const float*)(ws + WS_ROPC) + SEQ * 16, pos, 16, (w - 64) >> 1);
#pragma unroll
                        for (int j = 0; j < 8; ++j) v[j] *= QSCALE_C;
                        *(GAS u32x4*)((GAS bf16*)(ws + WS_QM) + (size_t)row * 768 + c) = pack8(v);
                    } else if (MODE == EPI_UKV) {
                        GAS bf16* dst = (c < 512) ? (GAS bf16*)(ws + WS_KN) + (size_t)row * KROW + c : (GAS bf16*)(ws + WS_VM) + (size_t)row * 512 + (c - 512);
                        *(GAS u32x4*)dst = pack8(v);
                    }
                }
                if (MODE == EPI_RES) {
                    sq += __shfl_xor(sq, 16); sq += __shfl_xor(sq, 32);
                    if (fq == 0) ssl[(ai * 128 + wr * 64 + m * 16 + fr) * 4 + wc] = sq;
                }
                if (MODE == EPI_OIN) {
                    if (u.pn <= 1) {
                        sq += __shfl_xor(sq, 16); sq += __shfl_xor(sq, 32);
                        if (fq == 0) ((GAS float*)(ws + (u.pn == 0 ? WS_SSQ : WS_SSKV)))[(size_t)row * 4 + wc] = sq;
                    }
                }
            }
        if (MODE == EPI_RES) {
            asm volatile("s_waitcnt lgkmcnt(0)" ::: "memory"); __builtin_amdgcn_s_barrier(); asm volatile("" ::: "memory");
            const int t = (wr * 4 + wc) * 64 + fq * 16 + fr;
            if (t < 256) { const f32x4 p = *(const LAS f32x4*)(ssl + t * 4); ssout[(size_t)(u.pm * 256 + t) * 4 + u.pn] = (p.x + p.y) + (p.z + p.w); }
        }
    }
};

template <int NKS, int KPITCH, bool MASK>
DI void attn_tile(const LAS unsigned char* Kt, const LAS unsigned char* Vt, const bf16x8 (&qf)[NKS], f32x16 (&o)[2], float& m, float& l, int r, int hh, int lane, int kvpos0, int qpos) {
    f32x16 s0, s1;
#pragma unroll
    for (int i = 0; i < 16; ++i) { s0[i] = 0.f; s1[i] = 0.f; }
    const LAS unsigned char* kp = Kt + r * KPITCH + hh * 16;
#pragma unroll
    for (int ks = 0; ks < NKS; ++ks) {
        const bf16x8 a0 = *(const LAS bf16x8*)(kp + ks * 32);
        const bf16x8 a1 = *(const LAS bf16x8*)(kp + 32 * KPITCH + ks * 32);
        s0 = MFMA32(a0, qf[ks], s0); s1 = MFMA32(a1, qf[ks], s1);
    }
    if (MASK) {
#pragma unroll
        for (int i = 0; i < 16; ++i) {
            const int kv = kvpos0 + crow(i, hh), kv1 = kv + 32;
            const int d0 = kv - qpos, d1 = kv1 - qpos;
            if (!(kv >= 0 && kv < SEQ && d0 <= 128 && d0 >= -128)) s0[i] = -1e30f;
            if (!(kv1 >= 0 && kv1 < SEQ && d1 <= 128 && d1 >= -128)) s1[i] = -1e30f;
        }
    }
    float mx = fmaxf(s0[0], s1[0]);
#pragma unroll
    for (int i = 1; i < 16; ++i) mx = fmaxf(mx, fmaxf(s0[i], s1[i]));
    mx = swap_max(mx);
    if (__any(mx > m + 8.f)) {
        const float mn = fmaxf(m, mx); const float al = __builtin_amdgcn_exp2f(m - mn);
        l *= al;
#pragma unroll
        for (int i = 0; i < 16; ++i) { o[0][i] *= al; o[1][i] *= al; }
        m = mn;
    }
    float rs = 0.f;
#pragma unroll
    for (int i = 0; i < 16; ++i) { s0[i] = __builtin_amdgcn_exp2f(s0[i] - m); s1[i] = __builtin_amdgcn_exp2f(s1[i] - m); rs += s0[i] + s1[i]; }
    l += rs;
    bf16x8 pb[2][2];
#pragma unroll
    for (int s = 0; s < 2; ++s) {
        u32x4 w0, w1;
        w0.x = cvtpk(s0[8 * s + 0], s0[8 * s + 1]); w0.y = cvtpk(s0[8 * s + 2], s0[8 * s + 3]); w0.z = cvtpk(s0[8 * s + 4], s0[8 * s + 5]); w0.w = cvtpk(s0[8 * s + 6], s0[8 * s + 7]);
        w1.x = cvtpk(s1[8 * s + 0], s1[8 * s + 1]); w1.y = cvtpk(s1[8 * s + 2], s1[8 * s + 3]); w1.z = cvtpk(s1[8 * s + 4], s1[8 * s + 5]); w1.w = cvtpk(s1[8 * s + 6], s1[8 * s + 7]);
        pb[0][s] = __builtin_bit_cast(bf16x8, w0); pb[1][s] = __builtin_bit_cast(bf16x8, w1);
    }
    const LAS unsigned char* vp = Vt + (4 * hh + ((lane & 15) >> 2)) * 64 + ((lane >> 4) & 1) * 32 + (lane & 3) * 8;
#pragma unroll
    for (int db = 0; db < 2; ++db)
#pragma unroll
        for (int kvh = 0; kvh < 2; ++kvh)
#pragma unroll
            for (int s = 0; s < 2; ++s) {
                const s16x4 lo = vtr(vp + db * 4096 + (32 * kvh + 16 * s) * 64), hi = vtr(vp + db * 4096 + (32 * kvh + 16 * s + 8) * 64);
                const bf16x8 vf = __builtin_shufflevector(lo, hi, 0, 1, 2, 3, 4, 5, 6, 7);
                o[db] = MFMA32(vf, pb[kvh][s], o[db]);
            }
}
DI void attn_store(const f32x16 (&o)[2], float l, bf16* yrow, int hh) {
    const float inv = 1.f / swap_sum(l);
#pragma unroll
    for (int db = 0; db < 2; ++db)
#pragma unroll
        for (int g4 = 0; g4 < 4; ++g4) {
            u32x2 w; w.x = cvtpk(o[db][4 * g4] * inv, o[db][4 * g4 + 1] * inv); w.y = cvtpk(o[db][4 * g4 + 2] * inv, o[db][4 * g4 + 3] * inv);
            *(u32x2*)(yrow + 32 * db + 8 * g4 + 4 * hh) = w;
        }
}

DI void glds16(const void* gsrc, unsigned lds_dst) { unsigned keep;
    asm volatile("s_mov_b32 %0, m0\n\ts_mov_b32 m0, %2\n\ts_nop 0\n\tglobal_load_lds_dwordx4 %1, off\n\ts_mov_b32 m0, %0" : "=&s"(keep) : "v"(gsrc), "s"(lds_dst) : "memory"); }
DI void mla_unit(const bf16* __restrict__ QM, const bf16* __restrict__ KN, const bf16* __restrict__ KR, const bf16* __restrict__ VM, bf16* __restrict__ Y, int b, int h, int qb, LAS unsigned char* lds, int wv) {
    int tid_ = wv * 64 + lane_id(); asm volatile("" : "+v"(tid_));
    const int tid = tid_, lane = tid & 63, wave = __builtin_amdgcn_readfirstlane(tid >> 6), r = lane & 31, hh = lane >> 5;
    constexpr int KSLOT = 16384, VSLOT = 8192, STG = KSLOT + VSLOT, ND = 4, NT = SEQ / 64;
    const size_t tok0 = (size_t)b * SEQ; const int q0 = qb * 256 + wave * 32;
    const unsigned lds0 = (unsigned)(uintptr_t)lds;
    const __amdgpu_buffer_rsrc_t srdK = __builtin_amdgcn_make_buffer_rsrc((void*)(KN + tok0 * KROW), (short)0, (int)(SEQ * KROW * 2), 0x00020000);
    const __amdgpu_buffer_rsrc_t srdV = __builtin_amdgcn_make_buffer_rsrc((void*)(VM + tok0 * 512), (short)0, (int)(SEQ * 1024), 0x00020000);
    unsigned vk0, vk1, vv0;
    {   const int pos = lane & 15, row0 = 4 * wave + (lane >> 4);
        int c_ = pos ^ (row0 & 15);
        if (c_ >= 12) c_ = 0;
        const unsigned goff = (c_ < 8) ? (unsigned)(h * 128 + c_ * 16) : (unsigned)(1024 + (c_ - 8) * 16);
        vk0 = (unsigned)row0 * (KROW * 2) + goff; vk1 = vk0 + 32u * (KROW * 2);
        vv0 = (unsigned)(16 * (wave & 3) + (lane >> 2)) * 1024u + (unsigned)(h * 128 + ((wave >> 2) * 4 + (lane & 3)) * 16); }
    const unsigned dk0 = lds0 + wave * 1024, dk1 = lds0 + (8 + wave) * 1024, dv0 = lds0 + KSLOT + wave * 1024;
#define BGLDS(VOFF, SRD, SOFF, M0V) asm volatile("s_mov_b32 m0, %0\n\ts_nop 0\n\tbuffer_load_dwordx4 %1, %2, %3 offen lds" :: "s"(M0V), "v"(VOFF), "s"(SRD), "s"(SOFF) : "m0", "memory")
#define MLA_ISSUE(J) do { const int j_ = (J); const int kt_ = (j_ + 1 < NT) ? j_ + 1 : NT - 1, vt_ = (j_ < 0) ? 0 : ((j_ < NT) ? j_ : NT - 1); \
        const unsigned so_ = (unsigned)(((j_ + ND) % ND) * STG); const unsigned ks_ = (unsigned)kt_ * (64u * KROW * 2u), vs_ = (unsigned)vt_ * (64u * 1024u); \
        BGLDS(vk0, srdK, ks_, (unsigned)__builtin_amdgcn_readfirstlane(dk0 + so_)); \
        BGLDS(vk1, srdK, ks_, (unsigned)__builtin_amdgcn_readfirstlane(dk1 + so_)); \
        BGLDS(vv0, srdV, vs_, (unsigned)__builtin_amdgcn_readfirstlane(dv0 + so_)); } while (0)
    MLA_ISSUE(-1); MLA_ISSUE(0); MLA_ISSUE(1); MLA_ISSUE(2);
    bf16x8 qf[6];
#pragma unroll
    for (int ks = 0; ks < 6; ++ks) qf[ks] = *(const bf16x8*)(QM + (tok0 + q0 + r) * 768 + h * 96 + ks * 16 + hh * 8);
    asm volatile("" : "+v"(qf[0]), "+v"(qf[1]), "+v"(qf[2]), "+v"(qf[3]), "+v"(qf[4]), "+v"(qf[5]));
    asm volatile("s_waitcnt vmcnt(0)\n\ts_barrier" ::: "memory");
    const int krow = r * 256, ky = (hh ^ (r & 15)) << 4;
    int kpo[6];
#pragma unroll
    for (int ks = 0; ks < 6; ++ks) kpo[ks] = (32 * ks) ^ ky;
    const int vro = KSLOT + (4 * hh + ((lane & 15) >> 2)) * 64 + ((lane >> 4) & 1) * 32 + (lane & 3) * 8;
    f32x16 c0, c1, o[2], negm;
#pragma unroll
    for (int i = 0; i < 16; ++i) { c0[i] = 0.f; c1[i] = 0.f; o[0][i] = 0.f; o[1][i] = 0.f; }
    {   const LAS unsigned char* kb = lds + (ND - 1) * STG + krow;
#pragma unroll
        for (int ks = 0; ks < 6; ++ks) {
            const int po = (32 * ks) ^ ky;
            const bf16x8 a0 = *(const LAS bf16x8*)(kb + po), a1 = *(const LAS bf16x8*)(kb + 32 * 256 + po);
            c0 = MFMA32(a0, qf[ks], c0); c1 = MFMA32(a1, qf[ks], c1);
        } }
    float m, l = 0.f;
    { float mx = fmaxf(c0[0], c1[0]);
#pragma unroll
      for (int i = 1; i < 16; ++i) mx = fmaxf(mx, fmaxf(c0[i], c1[i]));
      m = swap_max(mx);
#pragma unroll
      for (int i = 0; i < 16; ++i) { c0[i] -= m; c1[i] -= m; negm[i] = -m; } }
    asm volatile("s_waitcnt lgkmcnt(0)\n\ts_barrier" ::: "memory");
#define SB() __builtin_amdgcn_sched_barrier(0)
#define KLD(ks) do { ka[ks] = *(const LAS bf16x8*)(kb + kpo[ks]); kc[ks] = *(const LAS bf16x8*)(kb + 32 * 256 + kpo[ks]); } while (0)
#define EXO(C0, C1, i) do { C0[i] = __builtin_amdgcn_exp2f(C0[i]); C1[i] = __builtin_amdgcn_exp2f(C1[i]); } while (0)
#define ADS(C0, C1, i) do { rsum += C0[i]; rsum += C1[i]; } while (0)
#define PCK(kvh, s, c) do { u32x4 w_; w_.x = cvtpk(c[8 * s + 0], c[8 * s + 1]); w_.y = cvtpk(c[8 * s + 2], c[8 * s + 3]); w_.z = cvtpk(c[8 * s + 4], c[8 * s + 5]); w_.w = cvtpk(c[8 * s + 6], c[8 * s + 7]); pb[kvh][s] = __builtin_bit_cast(bf16x8, w_); } while (0)
#define VLD(j) do { const int o_ = ((j) & 1) * 4096 + (((j) >> 1) * 16) * 64; vlo[(j) & 3] = vtr(vc + o_); vhi[(j) & 3] = vtr(vc + o_ + 8 * 64); } while (0)
#define PVM(j) do { o[(j) & 1] = MFMA32(__builtin_shufflevector(vlo[(j) & 3], vhi[(j) & 3], 0, 1, 2, 3, 4, 5, 6, 7), pb[(j) >> 2][((j) >> 1) & 1], o[(j) & 1]); } while (0)
#define MX4(N0, N1, i) do { mi = max(max(mi, __float_as_int(N0[i])), __float_as_int(N1[i])); mi = max(max(mi, __float_as_int(N0[i + 1])), __float_as_int(N1[i + 1])); } while (0)
#define MLA_BODY(T, C0, C1, N0, N1) do { const int t = (T); \
        MLA_ISSUE(t + ND - 1);                                                  \
        const LAS unsigned char* sb = lds + (t % ND) * STG; \
        const LAS unsigned char* kb = sb + krow; \
        const LAS unsigned char* vc = sb + vro; \
        bf16x8 ka[6], kc[6], pb[2][2]; s16x4 vlo[4], vhi[4]; float rsum = 0.f; \
        KLD(0); KLD(1); KLD(2); SB(); \
        N0 = MFMA32(ka[0], qf[0], negm); N1 = MFMA32(kc[0], qf[0], negm); KLD(3); EXO(C0, C1, 0); EXO(C0, C1, 1); EXO(C0, C1, 2); SB(); \
        N0 = MFMA32(ka[1], qf[1], N0); N1 = MFMA32(kc[1], qf[1], N1); KLD(4); EXO(C0, C1, 3); EXO(C0, C1, 4); EXO(C0, C1, 5); ADS(C0, C1, 0); ADS(C0, C1, 1); ADS(C0, C1, 2); SB(); \
        N0 = MFMA32(ka[2], qf[2], N0); N1 = MFMA32(kc[2], qf[2], N1); KLD(5); EXO(C0, C1, 6); EXO(C0, C1, 7); ADS(C0, C1, 3); ADS(C0, C1, 4); ADS(C0, C1, 5); SB(); \
        N0 = MFMA32(ka[3], qf[3], N0); N1 = MFMA32(kc[3], qf[3], N1); VLD(0); VLD(1); EXO(C0, C1, 8); EXO(C0, C1, 9); EXO(C0, C1, 10); ADS(C0, C1, 6); ADS(C0, C1, 7); PCK(0, 0, C0); PCK(1, 0, C1); SB(); \
        N0 = MFMA32(ka[4], qf[4], N0); N1 = MFMA32(kc[4], qf[4], N1); VLD(2); VLD(3); EXO(C0, C1, 11); EXO(C0, C1, 12); EXO(C0, C1, 13); ADS(C0, C1, 8); ADS(C0, C1, 9); ADS(C0, C1, 10); SB(); \
        N0 = MFMA32(ka[5], qf[5], N0); N1 = MFMA32(kc[5], qf[5], N1); EXO(C0, C1, 14); EXO(C0, C1, 15); ADS(C0, C1, 11); ADS(C0, C1, 12); ADS(C0, C1, 13); SB(); \
        ADS(C0, C1, 14); ADS(C0, C1, 15); PCK(0, 1, C0); PCK(1, 1, C1); l += rsum; \
        int mi = (int)0x80000000; \
        PVM(0); VLD(4); \
        PVM(1); VLD(5); \
        PVM(2); VLD(6); MX4(N0, N1, 0); \
        PVM(3); VLD(7); MX4(N0, N1, 2); \
        PVM(4); MX4(N0, N1, 4); MX4(N0, N1, 6); \
        PVM(5); MX4(N0, N1, 8); MX4(N0, N1, 10); \
        PVM(6); MX4(N0, N1, 12); \
        PVM(7); MX4(N0, N1, 14); \
        { auto rr_ = __builtin_amdgcn_permlane32_swap((unsigned)mi, (unsigned)mi, false, false); mi = max((int)rr_[0], (int)rr_[1]); } \
        if (__any(mi > 0x41000000)) {          \
            const float mx = __int_as_float(mi); const float dl = fmaxf(mx, 0.f), f = __builtin_amdgcn_exp2f(-dl); \
            m += dl; l *= f; \
            _Pragma("unroll") for (int i = 0; i < 16; ++i) { N0[i] -= dl; N1[i] -= dl; negm[i] = -m; o[0][i] *= f; o[1][i] *= f; } \
        } \
          \
        asm volatile("s_waitcnt vmcnt(6) lgkmcnt(0)\n\ts_barrier" ::: "memory"); } while (0)
    f32x16 d0, d1;
    static_assert((NT - 1) % 2 == 1, "one peeled iteration, then pairs");
    if (wave >= 4) __builtin_amdgcn_s_setprio(1);
    MLA_BODY(0, c0, c1, d0, d1);
    asm volatile(".p2align 6" ::: "memory");
    for (int t2 = 1; t2 < NT - 1; t2 += 2) { MLA_BODY(t2, d0, d1, c0, c1); MLA_BODY(t2 + 1, c0, c1, d0, d1); }
    c0 = d0; c1 = d1;
    __builtin_amdgcn_s_setprio(0);
#undef MLA_BODY
#undef KLD
#undef EXO
#undef ADS
#undef PCK
#undef VLD
#undef PVM
#undef MX4
#undef SB
    {
        const LAS unsigned char* vc = lds + ((NT - 1) % ND) * STG + vro;
        float rs0 = 0.f, rs1 = 0.f;
#pragma unroll
        for (int i = 0; i < 16; ++i) { c0[i] = __builtin_amdgcn_exp2f(c0[i]); c1[i] = __builtin_amdgcn_exp2f(c1[i]); rs0 += c0[i]; rs1 += c1[i]; }
        l += rs0 + rs1;
#pragma unroll
        for (int db = 0; db < 2; ++db)
#pragma unroll
            for (int kvh = 0; kvh < 2; ++kvh)
#pragma unroll
                for (int s = 0; s < 2; ++s) {
                    u32x4 w; const f32x16& c = kvh ? c1 : c0;
                    w.x = cvtpk(c[8 * s + 0], c[8 * s + 1]); w.y = cvtpk(c[8 * s + 2], c[8 * s + 3]); w.z = cvtpk(c[8 * s + 4], c[8 * s + 5]); w.w = cvtpk(c[8 * s + 6], c[8 * s + 7]);
                    const s16x4 lo = vtr(vc + db * 4096 + (32 * kvh + 16 * s) * 64), hi = vtr(vc + db * 4096 + (32 * kvh + 16 * s + 8) * 64);
                    o[db] = MFMA32(__builtin_shufflevector(lo, hi, 0, 1, 2, 3, 4, 5, 6, 7), __builtin_bit_cast(bf16x8, w), o[db]);
                }
    }
#undef MLA_ISSUE
#undef BGLDS
    attn_store(o, l, Y + (tok0 + q0 + r) * 1024 + h * 64, hh);
    asm volatile("s_waitcnt vmcnt(0) lgkmcnt(0)\n\ts_barrier" ::: "memory");
}

DI void win_unit(const bf16* __restrict__ Q, const bf16* __restrict__ K, const bf16* __restrict__ V, const float* __restrict__ sink, bf16* __restrict__ Y, int b, int qblk, int g, LAS unsigned char* lds, int wv) {
    int tid_ = wv * 64 + lane_id(); asm volatile("" : "+v"(tid_));
    const int tid = tid_, lane = tid & 63, wave = __builtin_amdgcn_readfirstlane(tid >> 6), r = lane & 31, hh = lane >> 5;
    constexpr int KP = 144, KALL = 320 * KP, VT = 8192;
    const size_t tok0 = (size_t)b * SEQ; const int q0 = qblk * 64, kbase = q0 - 128;
#pragma unroll
    for (int it = 0; it < 5; ++it) {
        const int id = tid + it * 512, row = id >> 3, ch = id & 7, pos = kbase + row;
        u32x4 kk = {0u, 0u, 0u, 0u}, vv = {0u, 0u, 0u, 0u};
        if (pos >= 0 && pos < SEQ) { kk = *(const u32x4*)(K + (tok0 + pos) * 128 + g * 64 + ch * 8); vv = *(const u32x4*)(V + (tok0 + pos) * 128 + g * 64 + ch * 8); }
        *(LAS u32x4*)(lds + row * KP + ch * 16) = kk;
        *(LAS u32x4*)(lds + KALL + (row >> 6) * VT + (ch >> 2) * 4096 + (row & 63) * 64 + (ch & 3) * 16) = vv;
    }
    const int hq = g * 4 + (wave >> 1), qw = q0 + (wave & 1) * 32;
    bf16x8 qf[4];
#pragma unroll
    for (int ks = 0; ks < 4; ++ks) qf[ks] = *(const bf16x8*)(Q + (tok0 + qw + r) * 512 + hq * 64 + ks * 16 + hh * 8);
    __syncthreads();
    float m = sink[hq] * LOG2E, l = (hh == 0) ? 1.f : 0.f; f32x16 o[2];
#pragma unroll
    for (int i = 0; i < 16; ++i) { o[0][i] = 0.f; o[1][i] = 0.f; }
    const bool edge = (qblk == 0) || (qblk == SEQ / 64 - 1);
    for (int t = 0; t < 5; ++t) {
        if (t == 0 || t == 4 || edge) attn_tile<4, KP, true>(lds + t * 64 * KP, lds + KALL + t * VT, qf, o, m, l, r, hh, lane, kbase + 64 * t, qw + r);
        else attn_tile<4, KP, false>(lds + t * 64 * KP, lds + KALL + t * VT, qf, o, m, l, r, hh, lane, kbase + 64 * t, qw + r);
    }
    attn_store(o, l, Y + (tok0 + qw + r) * 1024 + hq * 64, hh);
    __syncthreads();
}

template <int HALF>
DI void pool_rows(const bf16* __restrict__ ub, bf16* __restrict__ yb, int s0) {
    float win[8], own[8][8];
#pragma unroll
    for (int q = 0; q < 8; ++q) win[q] = 0.f;
#pragma unroll
    for (int j = -HALF; j < HALF; ++j) { const int ss = s0 + j; u32x4 raw = {0u, 0u, 0u, 0u}; if (ss >= 0 && ss < SEQ) raw = *(const u32x4*)(ub + (size_t)ss * 512);
        float v[8]; unpack8(raw, v);
#pragma unroll
        for (int q = 0; q < 8; ++q) win[q] += v[q];
        if (j >= 0 && j < 8) {
#pragma unroll
            for (int q = 0; q < 8; ++q) own[j][q] = v[q]; } }
    if (HALF < 8) {
#pragma unroll
        for (int j = HALF; j < 8; ++j) { float v[8]; unpack8(*(const u32x4*)(ub + (size_t)(s0 + j) * 512), v);
#pragma unroll
            for (int q = 0; q < 8; ++q) own[j][q] = v[q]; } }
#pragma unroll
    for (int tt = 0; tt < 8; ++tt) {
        const int s = s0 + tt, lo = (s - HALF) < 0 ? 0 : (s - HALF), hi = (s + HALF) > SEQ ? SEQ : (s + HALF);
        const float ic = 1.f / (float)(hi - lo);
        float d[8];
#pragma unroll
        for (int q = 0; q < 8; ++q) d[q] = win[q] * ic - own[tt][q];
        *(u32x4*)(yb + (size_t)s * 1024) = pack8(d);
        if (tt < 7) {
            const int se = s + HALF, sl = s - HALF;
            u32x4 re = {0u, 0u, 0u, 0u}, rl = {0u, 0u, 0u, 0u};
            if (se < SEQ) re = *(const u32x4*)(ub + (size_t)se * 512);
            if (sl >= 0) rl = *(const u32x4*)(ub + (size_t)sl * 512);
            float ve[8], vl[8]; unpack8(re, ve); unpack8(rl, vl);
#pragma unroll
            for (int q = 0; q < 8; ++q) win[q] += ve[q] - vl[q];
        }
    }
}
DI void pool_unit(const bf16* __restrict__ U, bf16* __restrict__ Y, int unit, int wv) {
    int tid_ = wv * 64 + lane_id(); asm volatile("" : "+v"(tid_));
    const int tid = tid_, lane = tid & 63, wave = __builtin_amdgcn_readfirstlane(tid >> 6), g = wave >> 1, lp = (wave & 1) * 64 + lane, cgi = lp & 15, tsub = lp >> 4;
    const int tokbase = unit * 64 + tsub * 8, b = tokbase / SEQ, s0 = tokbase & (SEQ - 1), ch = g * 128 + cgi * 8;
    const bf16* ub = U + (size_t)b * SEQ * 512 + ch; bf16* yb = Y + (size_t)b * SEQ * 1024 + 512 + ch;
    if (g == 0) pool_rows<1>(ub, yb, s0); else if (g == 1) pool_rows<2>(ub, yb, s0); else if (g == 2) pool_rows<4>(ub, yb, s0); else pool_rows<8>(ub, yb, s0);
}

template <int CTRL, int ROWMASK> DI float dppf(float old, float src) { return __int_as_float(__builtin_amdgcn_update_dpp(__float_as_int(old), __float_as_int(src), CTRL, ROWMASK, 0xF, false)); }
DI float rdlane(float v, int l) { return __int_as_float(__builtin_amdgcn_readlane(__float_as_int(v), l)); }
DI float sigm_fast(float x) { return __builtin_amdgcn_rcpf(1.f + __expf(-x)); }
DI void scan_fwd(float& a, float& b) {
#define SCF(D) { const float ap = dppf<0x110 + D, 0xF>(1.f, a), bp = dppf<0x110 + D, 0xF>(0.f, b); b = a * bp + b; a = a * ap; }
    SCF(1) SCF(2) SCF(4) SCF(8)
#undef SCF
    { const float ap = dppf<0x142, 0xA>(1.f, a), bp = dppf<0x142, 0xA>(0.f, b); b = a * bp + b; a = a * ap; }
}
DI void scan_bwd(float& a, float& b, bool lowrow, bool hi) {
#define SCB(D) { const float an = dppf<0x100 + D, 0xF>(1.f, a), bn = dppf<0x100 + D, 0xF>(0.f, b); b = a * bn + b; a = a * an; }
    SCB(1) SCB(2) SCB(4) SCB(8)
#undef SCB
    { const float a16 = rdlane(a, 16), a48 = rdlane(a, 48), b16 = rdlane(b, 16), b48 = rdlane(b, 48);
      const float an = lowrow ? (hi ? a48 : a16) : 1.f, bn = lowrow ? (hi ? b48 : b16) : 0.f; b = a * bn + b; a = a * an; }
}
DI void lru_ab(float pa, float px, float ba, float bx, float sp, float xcv, float& a, float& bb) {
    const float rg = sigm_fast(pa + ba), ig = sigm_fast(px + bx);
    const float la = -8.f * rg * sp; a = __expf(la);
    const float om = fmaxf(1.f - a * a, 0.f);
    bb = __builtin_amdgcn_sqrtf(om) * (ig * xcv);
}
template <int MODE>
DI void lru_phase(const Params& P, int o, LAS unsigned char* lds, int wv, int bx, int G) {
    int tid_ = wv * 64 + lane_id(); asm volatile("" : "+v"(tid_));
    const int tid = tid_, lane = tid & 63, wave = __builtin_amdgcn_readfirstlane(tid >> 6), r = lane & 31, hh = lane >> 5;
    unsigned char* ws = P.ws;
    LAS unsigned char* WG = lds; LAS float* PRM = (LAS float*)(lds + 36864); LAS float* CAR = (LAS float*)(lds + 40960); LAS float* SEG = (LAS float*)(lds + 45056);
    LAS float* XC = (LAS float*)(lds + 53248) + wave * (32 * 65);
    const bf16* XR = (const bf16*)(ws + WS_XR); const bf16* GXG = (const bf16*)(ws + WS_GXG); bf16* Y = (bf16*)(ws + WS_Y);
    f32x2* SUM = (f32x2*)(ws + WS_SUM); f32x2* CSUM = (f32x2*)(ws + WS_CSUM);
    const int n = bx & 7;
    {
        const bf16* wg = (const bf16*)(ws + WS_WG) + (size_t)((o * 8 + n) * 4) * 4096;
#pragma unroll
        for (int it = 0; it < 4; ++it) { const int q = tid + it * 512, g = q >> 9, rem = q & 511, j = rem >> 3, ch = rem & 7;
            *(LAS u32x4*)(WG + (g * 64 + j) * 144 + ch * 16) = *(const u32x4*)(wg + g * 4096 + j * 64 + ch * 8); }
        for (int q = tid; q < 11 * 64; q += 512) {
            const int k = q >> 6, chl = q & 63, ch = 64 * n + chl; float v;
            if (k == 0) v = P.in[16][(o * 2 + 0) * 512 + ch]; else if (k == 1) v = P.in[18][(o * 2 + 0) * 512 + ch];
            else if (k == 2) v = P.in[16][(o * 2 + 1) * 512 + ch]; else if (k == 3) v = P.in[18][(o * 2 + 1) * 512 + ch];
            else if (k < 6) v = ((const float*)(ws + WS_SP))[(o * 2 + (k - 4)) * 512 + ch];
            else if (k < 10) v = P.in[13][(size_t)(o * 4 + (k - 6)) * 512 + ch];
            else v = P.in[14][o * 512 + ch];
            PRM[k * 64 + chl] = v;
        }
    }
    __syncthreads();
    for (int u = bx; u < 2 * 64 * 8; u += G) {
        const int c = (u >> 3) & 63, b = u >> 9;
        if (MODE == 1) {
            if (wave == 6) {
                const f32x2* cs = CSUM + (size_t)((0 * 2 + b) * 64) * 512 + 64 * n + lane; float cf = 0.f;
                for (int cc0 = 0; cc0 < c; cc0 += 8) {
                    f32x2 ab[8];
#pragma unroll
                    for (int j = 0; j < 8; ++j) { const int cc = cc0 + j; ab[j] = cs[(size_t)(cc < c ? cc : 0) * 512]; }
#pragma unroll
                    for (int j = 0; j < 8; ++j) if (cc0 + j < c) cf = ab[j].x * cf + ab[j].y;
                }
                const f32x2* ss = SUM + (size_t)((0 * 2 + b) * 512 + 8 * c) * 512 + 64 * n + lane;
                { f32x2 ab[8];
#pragma unroll
                  for (int w = 0; w < 8; ++w) ab[w] = ss[(size_t)w * 512];
#pragma unroll
                  for (int w = 0; w < 8; ++w) { CAR[w * 64 + lane] = cf; cf = ab[w].x * cf + ab[w].y; } }
            } else if (wave == 7) {
                const f32x2* cs = CSUM + (size_t)((1 * 2 + b) * 64) * 512 + 64 * n + lane; float cb = 0.f;
                for (int cc0 = 63; cc0 > c; cc0 -= 8) {
                    f32x2 ab[8];
#pragma unroll
                    for (int j = 0; j < 8; ++j) { const int cc = cc0 - j; ab[j] = cs[(size_t)(cc > c ? cc : 63) * 512]; }
#pragma unroll
                    for (int j = 0; j < 8; ++j) if (cc0 - j > c) cb = ab[j].x * cb + ab[j].y;
                }
                const f32x2* ss = SUM + (size_t)((1 * 2 + b) * 512 + 8 * c) * 512 + 64 * n + lane;
                { f32x2 ab[8];
#pragma unroll
                  for (int w = 0; w < 8; ++w) ab[w] = ss[(size_t)w * 512];
#pragma unroll
                  for (int w = 7; w >= 0; --w) { CAR[512 + w * 64 + lane] = cb; cb = ab[w].x * cb + ab[w].y; } }
            }
        }
        const int t = c * 256 + wave * 32 + r; const size_t brow = (size_t)b * SEQ;
        bf16x8 bfrag[4];
#pragma unroll
        for (int ks = 0; ks < 4; ++ks) {
            const int chl0 = 16 * ks + 8 * hh, ch0 = 64 * n + chl0;
            float xc[8];
            { const f32x4 b0 = *(const LAS f32x4*)(PRM + 10 * 64 + chl0), b1 = *(const LAS f32x4*)(PRM + 10 * 64 + chl0 + 4);
#pragma unroll
              for (int q = 0; q < 4; ++q) { xc[q] = b0[q]; xc[4 + q] = b1[q]; } }
#pragma unroll
            for (int j = 0; j < 4; ++j) {
                const int tt = t + j - 2;
                u32x4 raw = {0u, 0u, 0u, 0u};
                if (tt >= 0 && tt < SEQ) raw = *(const u32x4*)(XR + (brow + tt) * 512 + ch0);
                float xv[8]; unpack8(raw, xv);
                const f32x4 w0 = *(const LAS f32x4*)(PRM + (6 + j) * 64 + chl0), w1 = *(const LAS f32x4*)(PRM + (6 + j) * 64 + chl0 + 4);
#pragma unroll
                for (int q = 0; q < 4; ++q) { xc[q] += w0[q] * xv[q]; xc[4 + q] += w1[q] * xv[4 + q]; }
            }
#pragma unroll
            for (int q = 0; q < 8; ++q) XC[r * 65 + chl0 + q] = xc[q];
            bfrag[ks] = __builtin_bit_cast(bf16x8, pack8(xc));
        }
        if (MODE == 1) __syncthreads();
        f32x16 acc[4][2];
#pragma unroll
        for (int g = 0; g < 4; ++g)
#pragma unroll
            for (int hf = 0; hf < 2; ++hf) {
                f32x16 a;
#pragma unroll
                for (int i = 0; i < 16; ++i) a[i] = 0.f;
#pragma unroll
                for (int ks = 0; ks < 4; ++ks) { const bf16x8 wf = *(const LAS bf16x8*)(WG + (g * 64 + 32 * hf + r) * 144 + (16 * ks + 8 * hh) * 2); a = MFMA32(bfrag[ks], wf, a); }
                acc[g][hf] = a;
            }
        const size_t mrow0 = brow + c * 256 + wave * 32;
#pragma unroll
        for (int hf = 0; hf < 2; ++hf) {
            const int chl = 32 * hf + r;
            const float ba0 = PRM[0 * 64 + chl], bx0 = PRM[1 * 64 + chl], ba1 = PRM[2 * 64 + chl], bx1 = PRM[3 * 64 + chl], sp0 = PRM[4 * 64 + chl], sp1 = PRM[5 * 64 + chl];
            const LAS float* xcl = XC + (4 * hh) * 65 + chl;
            float PF[16], HF[16], PB[16], HB[16];
#pragma unroll
            for (int q = 0; q < 4; ++q) {
                float aF[4], bF[4], aB[4], bB[4];
#pragma unroll
                for (int e = 0; e < 4; ++e) { const int i = 4 * q + e; const float xcv = xcl[(e + 8 * q) * 65];
                    lru_ab(acc[0][hf][i], acc[1][hf][i], ba0, bx0, sp0, xcv, aF[e], bF[e]);
                    lru_ab(acc[2][hf][i], acc[3][hf][i], ba1, bx1, sp1, xcv, aB[e], bB[e]); }
                PF[4 * q] = aF[0]; HF[4 * q] = bF[0];
#pragma unroll
                for (int e = 1; e < 4; ++e) { PF[4 * q + e] = aF[e] * PF[4 * q + e - 1]; HF[4 * q + e] = aF[e] * HF[4 * q + e - 1] + bF[e]; }
                PB[4 * q + 3] = aB[3]; HB[4 * q + 3] = bB[3];
#pragma unroll
                for (int e = 2; e >= 0; --e) { PB[4 * q + e] = aB[e] * PB[4 * q + e + 1]; HB[4 * q + e] = aB[e] * HB[4 * q + e + 1] + bB[e]; }
            }
            float GAF[8], GBF[8], GAB[8], GBB[8];
#pragma unroll
            for (int q = 0; q < 4; ++q) {
                { auto rr = __builtin_amdgcn_permlane32_swap(__float_as_uint(PF[4 * q + 3]), __float_as_uint(PF[4 * q + 3]), false, false); GAF[2 * q] = __uint_as_float(rr[0]); GAF[2 * q + 1] = __uint_as_float(rr[1]); }
                { auto rr = __builtin_amdgcn_permlane32_swap(__float_as_uint(HF[4 * q + 3]), __float_as_uint(HF[4 * q + 3]), false, false); GBF[2 * q] = __uint_as_float(rr[0]); GBF[2 * q + 1] = __uint_as_float(rr[1]); }
                { auto rr = __builtin_amdgcn_permlane32_swap(__float_as_uint(PB[4 * q]), __float_as_uint(PB[4 * q]), false, false); GAB[2 * q] = __uint_as_float(rr[0]); GAB[2 * q + 1] = __uint_as_float(rr[1]); }
                { auto rr = __builtin_amdgcn_permlane32_swap(__float_as_uint(HB[4 * q]), __float_as_uint(HB[4 * q]), false, false); GBB[2 * q] = __uint_as_float(rr[0]); GBB[2 * q + 1] = __uint_as_float(rr[1]); }
            }
            if (MODE == 0) {
                float AF = 1.f, BF = 0.f, AB = 1.f, BB = 0.f;
#pragma unroll
                for (int k = 0; k < 8; ++k) { BF = GAF[k] * BF + GBF[k]; AF = GAF[k] * AF; }
#pragma unroll
                for (int k = 7; k >= 0; --k) { BB = GAB[k] * BB + GBB[k]; AB = GAB[k] * AB; }
                if (hh == 0) {
                    SEG[((0 * 8 + wave) * 64 + chl) * 2] = AF; SEG[((0 * 8 + wave) * 64 + chl) * 2 + 1] = BF; SEG[((1 * 8 + wave) * 64 + chl) * 2] = AB; SEG[((1 * 8 + wave) * 64 + chl) * 2 + 1] = BB;
                    SUM[(size_t)((0 * 2 + b) * 512 + 8 * c + wave) * 512 + 64 * n + chl] = (f32x2){AF, BF};
                    SUM[(size_t)((1 * 2 + b) * 512 + 8 * c + wave) * 512 + 64 * n + chl] = (f32x2){AB, BB};
                }
            } else {
                float hin[8], hib[8];
                hin[0] = CAR[wave * 64 + chl];
#pragma unroll
                for (int k = 0; k < 7; ++k) hin[k + 1] = GAF[k] * hin[k] + GBF[k];
                hib[7] = CAR[512 + wave * 64 + chl];
#pragma unroll
                for (int k = 7; k > 0; --k) hib[k - 1] = GAB[k] * hib[k] + GBB[k];
                const bf16* gxp = GXG + (mrow0 + 4 * hh) * 512 + 64 * n + chl; bf16* yp = Y + (mrow0 + 4 * hh) * 1024 + 512 + 64 * n + chl;
#pragma unroll
                for (int q = 0; q < 4; ++q) {
                    const float cf = hh ? hin[2 * q + 1] : hin[2 * q], cb = hh ? hib[2 * q + 1] : hib[2 * q];
#pragma unroll
                    for (int e = 0; e < 4; ++e) { const int i = 4 * q + e, tk = e + 8 * q;
                        const float h = (HF[i] + PF[i] * cf) + (HB[i] + PB[i] * cb);
                        const float gx = __uint_as_float((unsigned)gxp[(size_t)tk * 512] << 16);
                        yp[(size_t)tk * 1024] = (bf16)(cvtpk(h * gx, 0.f) & 0xffffu); }
                }
            }
        }
        if (MODE == 0) {
            __syncthreads();
            if (wave == 0) { float A = 1.f, B = 0.f;
                for (int w = 0; w < 8; ++w) { const float aw = SEG[((0 * 8 + w) * 64 + lane) * 2], bw = SEG[((0 * 8 + w) * 64 + lane) * 2 + 1]; B = aw * B + bw; A = aw * A; }
                CSUM[(size_t)((0 * 2 + b) * 64 + c) * 512 + 64 * n + lane] = (f32x2){A, B};
            } else if (wave == 1) { float A = 1.f, B = 0.f;
                for (int w = 7; w >= 0; --w) { const float aw = SEG[((1 * 8 + w) * 64 + lane) * 2], bw = SEG[((1 * 8 + w) * 64 + lane) * 2 + 1]; B = aw * B + bw; A = aw * A; }
                CSUM[(size_t)((1 * 2 + b) * 64 + c) * 512 + 64 * n + lane] = (f32x2){A, B};
            }
        }
        __syncthreads();
    }
}

#define RLX_AGENT __ATOMIC_RELAXED, __HIP_MEMORY_SCOPE_AGENT
#define XB_TMO      128
#define XB_XCNT(j)  (256  + 64 * (j))
#define XB_XSUB(j)  (1280 + 64 * (j))
#define XB_XGEN(j)  (2304 + 64 * (j))
#define XB_TOP      3328
#define XB_TOPGEN   3392
#define XCD_BAR_WORDS 3456
#define XB_SPIN_CAP (1u << 18)

__device__ __forceinline__ unsigned xb_ld(unsigned* p)              { return __hip_atomic_load(p, __ATOMIC_RELAXED, __HIP_MEMORY_SCOPE_AGENT); }
__device__ __forceinline__ unsigned xb_add(unsigned* p, unsigned v) { return __hip_atomic_fetch_add(p, v, __ATOMIC_RELAXED, __HIP_MEMORY_SCOPE_AGENT); }
__device__ __forceinline__ unsigned xb_xcc_id() { return (unsigned)__builtin_amdgcn_s_getreg((3 << 11) | 20) & 0xFu; }
#define XB_SPIN(cond, bar) do { unsigned _sp = 0; while (cond) { __builtin_amdgcn_s_sleep(1); \
    if ((++_sp & 255u) == 0u) { if (xb_ld(&(bar)[XB_TMO])) break; if (_sp > XB_SPIN_CAP) { atomicAdd(&(bar)[XB_TMO], 1u); break; } } } } while (0)

struct XcdBarrier {
    unsigned* bar; unsigned x; int wv;
    volatile LAS unsigned* st;
};

__device__ __forceinline__ XcdBarrier xcd_barrier_post(unsigned* bar, volatile LAS unsigned* st, int wv) {
    XcdBarrier b; b.bar = bar; b.x = xb_xcc_id(); b.st = st; b.wv = wv;
    if (wv == 0 && lane_id() == 0) (void)xb_add(&bar[XB_XCNT(b.x)], 1u);
    return b;
}
__device__ __forceinline__ void xcd_barrier_complete(unsigned* bar, unsigned x, unsigned& nloc, unsigned& nx) {
    const unsigned G = gridDim.x * gridDim.y * gridDim.z;
    unsigned sum, cnt, mine, sp = 0u;
    for (;;) {
        sum = 0u; cnt = 0u; mine = 0u;
#pragma unroll
        for (unsigned j = 0; j < 16; ++j) { const unsigned c = xb_ld(&bar[XB_XCNT(j)]); sum += c; cnt += (c > 0u) ? 1u : 0u; mine = (j == x) ? c : mine; }
        if (sum == G) break;
        __builtin_amdgcn_s_sleep(1);
        if ((++sp & 255u) == 0u) { if (xb_ld(&bar[XB_TMO])) break; if (sp > XB_SPIN_CAP) { atomicAdd(&bar[XB_TMO], 1u); break; } }
    }
    nloc = mine > 0u ? mine : 1u; nx = cnt > 0u ? cnt : 1u;
}

__device__ __forceinline__ void xcd_barrier(const XcdBarrier& b) {
    asm volatile("s_waitcnt vmcnt(0)" ::: "memory");
    __syncthreads();
    if (b.wv == 0 && lane_id() == 0) {
        unsigned* bar = b.bar;
        __builtin_amdgcn_s_waitcnt(0);
        unsigned nloc = b.st[0], nx = b.st[1];
        if (nloc == 0u) { xcd_barrier_complete(bar, b.x, nloc, nx); b.st[0] = nloc; b.st[1] = nx; }
        const unsigned old = xb_add(&bar[XB_XSUB(b.x)], 1u);
        const unsigned gen = old / nloc;
        if (old + 1u == (gen + 1u) * nloc) {
            __builtin_amdgcn_fence(__ATOMIC_RELEASE, "agent");
            asm volatile("s_waitcnt vmcnt(0)" ::: "memory");
            const unsigned og = xb_add(&bar[XB_TOP], 1u);
            const unsigned tg = og / nx;
            if (og + 1u == (tg + 1u) * nx) xb_add(&bar[XB_TOPGEN], 1u);
            else XB_SPIN(xb_ld(&bar[XB_TOPGEN]) == tg, bar);
            __builtin_amdgcn_fence(__ATOMIC_ACQUIRE, "agent");
            xb_add(&bar[XB_XGEN(b.x)], 1u);
            asm volatile("s_waitcnt vmcnt(0)" ::: "memory");
        } else {
            XB_SPIN(xb_ld(&bar[XB_XGEN(b.x)]) == gen, bar);
            __builtin_amdgcn_fence(__ATOMIC_ACQUIRE, "agent");
            asm volatile("s_waitcnt vmcnt(0)" ::: "memory");
        }
    }
    __syncthreads();
}

template <int MODE> DI void run_gemm(LAS unsigned char* lds, const bf16* A, const bf16* Bt, int N, int K, const Epi<MODE>& E, int G, int wv) {
    pg8::Gemm g{A, Bt, MTOK, N, K, wv}; pg8::StaticOrder S; S.init(MTOK, N, G, (int)blockIdx.x);
    pg8::gemm_phase<Epi<MODE>, pg8::StaticOrder, true, true>(lds, g, S, E);
}

__global__ void __launch_bounds__(512, 2) fwd_megakernel(Params P) {
    extern __shared__ __attribute__((aligned(16))) unsigned char lds_raw[];
    LAS unsigned char* lds = (LAS unsigned char*)lds_raw;
    cg::grid_group grid = cg::this_grid();
    const int G = gridDim.x, bx = blockIdx.x;
    const int wv0 = __builtin_amdgcn_readfirstlane((int)threadIdx.x >> 6);
    int tid0_ = wv0 * 64 + lane_id(); asm volatile("" : "+v"(tid0_)); const int tid = tid0_;
    unsigned char* ws = P.ws;
#define WS_FRESH() do { ws = P.ws; asm volatile("" : "+s"(ws)); } while (0)
    const int vcu = (G % 8 == 0) ? (bx % 8) * (G / 8) + bx / 8 : bx;
    volatile LAS unsigned* MISC = (volatile LAS unsigned*)(lds + (LDS_BYTES - 64));
    if (tid < 16) MISC[tid] = 0u;
    __syncthreads();
    XcdBarrier xbar = xcd_barrier_post((unsigned*)(ws + WS_CTL), MISC, wv0);

#if PH & 1
    for (int rep_ = 0; rep_ < PRO_REP; ++rep_)
    prologue(P, (long)bx * 512 + tid, (long)G * 512, lds);
#endif
    grid.sync();
#define GRID_BAR() xcd_barrier(xbar)

    for (int layer = 0; layer < DEPTH; ++layer) {
        const int li = layer >> 1;
        if ((layer & 1) == 0) {
            {   WS_FRESH();
                Epi<EPI_EIN> E{(GAS const float*)(ws + WS_SSP), nullptr, nullptr, nullptr, nullptr, (GAS unsigned char*)ws, lds};
#if PH & 2
                for (int rep_ = 0; rep_ < E1_REP; ++rep_)
                run_gemm<EPI_EIN>(lds, (const bf16*)(ws + WS_XB), (const bf16*)(ws + WS_EIN) + (size_t)li * 1280 * 1024, 1280, 1024, E, G, wv0);
#endif
            }
            GRID_BAR();
            {   WS_FRESH();
                const bf16* Q = (const bf16*)(ws + WS_Q); const bf16* K = (const bf16*)(ws + WS_K); const bf16* V = (const bf16*)(ws + WS_V);
#if PH & 4
                for (int rep_ = 0; rep_ < WIN_REP; ++rep_)
                for (int u = vcu; u < 2 * 256 * 2; u += G) { const int g = u & 1, qblk = (u >> 1) & 255, b = u >> 9; win_unit(Q, K, V, P.in[3] + li * 8, (bf16*)(ws + WS_Y), b, qblk, g, lds, wv0); }
#endif
#if PH & 8
                for (int rep_ = 0; rep_ < WIN_REP; ++rep_)
                for (int u = bx; u < MTOK / 64; u += G) pool_unit((const bf16*)(ws + WS_U), (bf16*)(ws + WS_Y), u, wv0);
#endif
            }
            GRID_BAR();
        } else {
            {   WS_FRESH();
                Epi<EPI_OIN> E{(GAS const float*)(ws + WS_SSP), nullptr, nullptr, nullptr, nullptr, (GAS unsigned char*)ws, lds};
#if PH & 16
                for (int rep_ = 0; rep_ < O1_REP; ++rep_)
                run_gemm<EPI_OIN>(lds, (const bf16*)(ws + WS_XB), (const bf16*)(ws + WS_OIN) + (size_t)li * 1536 * 1024, 1536, 1024, E, G, wv0);
#endif
            }
            GRID_BAR();
            {   WS_FRESH();
                Epi<EPI_UQ> E1{(GAS const float*)(ws + WS_SSQ), nullptr, nullptr, nullptr, nullptr, (GAS unsigned char*)ws, lds};
#if PH & 32
                for (int rep_ = 0; rep_ < O2_REP; ++rep_)
                run_gemm<EPI_UQ>(lds, (const bf16*)(ws + WS_CQ), (const bf16*)(ws + WS_UQ) + (size_t)li * 768 * 256, 768, 256, E1, G, wv0);
#endif
                Epi<EPI_UKV> E2{(GAS const float*)(ws + WS_SSKV), nullptr, nullptr, nullptr, nullptr, (GAS unsigned char*)ws, lds};
#if PH & 64
                for (int rep_ = 0; rep_ < O2_REP; ++rep_)
                run_gemm<EPI_UKV>(lds, (const bf16*)(ws + WS_CKV), (const bf16*)(ws + WS_UKV) + (size_t)li * 1024 * 128, 1024, 128, E2, G, wv0);
#endif
                __syncthreads();
#if PH & 128
                lru_phase<0>(P, li, lds, wv0, bx, G);
#endif
            }
            GRID_BAR();
            {   WS_FRESH();
                const bf16* QM = (const bf16*)(ws + WS_QM); const bf16* KN = (const bf16*)(ws + WS_KN); const bf16* KR = (const bf16*)(ws + WS_KR); const bf16* VM = (const bf16*)(ws + WS_VM);
#if PH & 256
                for (int rep_ = 0; rep_ < MLA_REP; ++rep_)
                for (int u = vcu; u < 2 * 8 * 64; u += G) {
                    int bh, qb;
                    if (G == 256) { const int xcd = vcu >> 5, idx = vcu & 31, i = u >> 8; bh = 2 * xcd + (i >> 1); qb = (i & 1) * 32 + idx; }
                    else { bh = u >> 6; qb = u & 63; }
                    mla_unit(QM, KN, KR, VM, (bf16*)(ws + WS_Y), bh >> 3, bh & 7, qb, lds, wv0);
                }
#endif
#if PH & 512
                lru_phase<1>(P, li, lds, wv0, bx, G);
#endif
            }
            GRID_BAR();
        }
        for (int half = 0; half < 2; ++half) {
            WS_FRESH();
            if (half == 1) {
                Epi<EPI_MLP1> E{(GAS const float*)(ws + WS_SSP), nullptr, nullptr, nullptr, nullptr, (GAS unsigned char*)ws, lds};
#if PH & 1024
                for (int rep_ = 0; rep_ < M1_REP; ++rep_)
                run_gemm<EPI_MLP1>(lds, (const bf16*)(ws + WS_XB), (const bf16*)(ws + WS_M1) + (size_t)layer * 4096 * 1024, 4096, 1024, E, G, wv0);
#endif
                GRID_BAR();
                WS_FRESH();
            }
            const bf16* A = half ? (const bf16*)(ws + WS_H) : (const bf16*)(ws + WS_Y);
            const bf16* Bt = half ? (const bf16*)(ws + WS_M2) + (size_t)layer * 4096 * 1024 : ((layer & 1) ? (const bf16*)(ws + WS_OOUT) : (const bf16*)(ws + WS_EOUT)) + (size_t)li * 1024 * 1024;
            const float* xold = (layer == 0 && half == 0) ? P.in[0] : P.out;
            Epi<EPI_RES> E{nullptr, nullptr, nullptr, (GAS bf16*)(ws + WS_XB), (GAS float*)(ws + WS_SSP), (GAS unsigned char*)ws, lds};
            (void)xold;
#if PH & 2048
            run_gemm<EPI_RES>(lds, A, Bt, 1024, half ? 4096 : 1024, E, G, wv0);
#endif
            GRID_BAR();
        }
    }
    for (int rep_ = 0; rep_ < SYNC_EXTRA; ++rep_) GRID_BAR();
    {   WS_FRESH();
        int tidf_ = wv0 * 64 + lane_id(); asm volatile("" : "+v"(tidf_));
        const long gw = ((long)bx * 512 + tidf_) >> 6, ngw = ((long)G * 512) >> 6; const int lane = tidf_ & 63;
        const float* ssp = (const float*)(ws + WS_SSP); const f32x4* gn = (const f32x4*)P.in[24] + lane;
        f32x4 g4[4];
#pragma unroll
        for (int j = 0; j < 4; ++j) g4[j] = gn[64 * j];
        for (long row = gw; row < MTOK; row += ngw) {
            const float rs = row_rstd<4>(ssp, (int)row, 1.f / 1024.f);
            f32x4* xr = (f32x4*)(P.out + (size_t)row * DM) + lane;
            const u32x2* xbr = (const u32x2*)((const bf16*)(ws + WS_XB) + (size_t)row * DM) + lane;
            u32x2 w[4];
#pragma unroll
            for (int j = 0; j < 4; ++j) w[j] = xbr[64 * j];
#pragma unroll
            for (int j = 0; j < 4; ++j) { const f32x4 v = {bflo(w[j].x), bfhi(w[j].x), bflo(w[j].y), bfhi(w[j].y)}; xr[64 * j] = v * rs * g4[j]; }
        }
    }
}

extern "C" void kernel_launch(void* const* d_in, const int* in_sizes, int n_in, void* d_out, int out_size, void* d_ws, size_t ws_size, hipStream_t stream) {
    static int grid = 0;
    if (grid == 0) {
        if (n_in != 25 || out_size != MTOK * DM || ws_size < WS_END) { fprintf(stderr, "kernel_launch: unexpected shapes (n_in %d, out %d, ws %zu)\n", n_in, out_size, ws_size); grid = -1; return; }
        int dev = 0, cus = 0, per = 0;
        (void)hipGetDevice(&dev); (void)hipDeviceGetAttribute(&cus, hipDeviceAttributeMultiprocessorCount, dev);
        (void)hipFuncSetAttribute((const void*)fwd_megakernel, hipFuncAttributeMaxDynamicSharedMemorySize, LDS_BYTES);
        (void)hipOccupancyMaxActiveBlocksPerMultiprocessor(&per, (const void*)fwd_megakernel, 512, LDS_BYTES);
        if (per < 1) per = 1;
        grid = cus * per;
        fprintf(stderr, "kernel_launch: grid %d (cus %d x %d)\n", grid, cus, per);
    }
    if (grid < 0) return;
    Params p{};
    for (int i = 0; i < 25; ++i) p.in[i] = (const float*)d_in[i];
    p.out = (float*)d_out; p.ws = (unsigned char*)d_ws;
    (void)hipMemsetAsync((char*)d_ws + WS_CTL, 0, CTL_ZERO_BYTES, stream);
    void* args[] = {&p};
    hipError_t e = hipLaunchCooperativeKernel((void*)fwd_megakernel, dim3(grid), dim3(512), args, LDS_BYTES, stream);
    if (e != hipSuccess) fprintf(stderr, "kernel_launch: cooperative launch failed: %s (grid %d)\n", hipGetErrorString(e), grid);
}
```
